# Optimizing an MI355X kernel written in HIP

```python
import jax, jax.numpy as jnp
from jax import lax
import numpy as np

D_MODEL = 2048
BATCH = 8
SEQ = 4096
DEPTH = 4

GRID_W = 64
CTX_LEN = 256
EPS = 1e-6
D_FF = 11 * D_MODEL // 4
N_MOD = 9
N_BRANCH = 3
A_HEADS = 4
A_W = D_MODEL // 2
A_DH = A_W // A_HEADS
B_DK = 128
B_W = D_MODEL // 2
B_HEADS = B_W // B_DK
C_W = D_MODEL // 2
C_BLOCKS = 16
C_DB = C_W // C_BLOCKS
CONV_W = 4
CONV_PAD = (2, 1)
RG_C = 8.0
CHUNK = 64
IN_SPLITS = (A_W, A_W, A_W, A_W, 4 * A_HEADS,
             B_W, B_W, B_W, B_W, B_W,
             C_W, C_W,
             N_BRANCH * D_MODEL)
IN_OFFSETS = tuple(int(v) for v in np.cumsum(IN_SPLITS)[:-1])
IN_WIDTH = int(sum(IN_SPLITS))

kernel_name = 'hybrid_mlstm_hgrn2_rglru_flow_block'


def rmsnorm(x, g):
    xf = x.astype(jnp.float32)
    y = xf * lax.rsqrt(jnp.mean(xf * xf, axis=-1, keepdims=True) + EPS)
    return y.astype(x.dtype) * g


def head_rms(x):
    return x * lax.rsqrt(jnp.mean(x * x, axis=-1, keepdims=True) + EPS)


def adaln(x, g, shift, scale):
    return rmsnorm(x, g) * (1 + scale) + shift


def swiglu(x, w_i, w_o):
    gate, up = jnp.split(x @ w_i, 2, axis=-1)
    return (jax.nn.silu(gate) * up) @ w_o


def to_heads(t, n):
    b, s, _ = t.shape
    return t.reshape(b, s, n, -1).transpose(0, 2, 1, 3).astype(jnp.float32)


def from_heads(t):
    b, n, s, d = t.shape
    return t.transpose(0, 2, 1, 3).reshape(b, s, n * d)


def to_chunks(t):
    b, n, s = t.shape[:3]
    t = t.reshape(b, n, s // CHUNK, CHUNK, *t.shape[3:])
    return jnp.moveaxis(t, 2, 0)


def from_chunks(t):
    t = jnp.moveaxis(t, 0, 2)
    b, n, nc, l = t.shape[:4]
    return t.reshape(b, n, nc * l, *t.shape[4:])


def mlstm_scan(q, k, v, logf, logi, state):
    mask = jnp.tril(jnp.ones((CHUNK, CHUNK), dtype=bool))

    def step(carry, xs):
        cmat, nvec, m = carry
        qc, kc, vc, fc, ic = xs
        b = jnp.cumsum(fc, axis=-1)
        dmat = jnp.where(mask, b[..., :, None] - b[..., None, :] + ic[..., None, :], -jnp.inf)
        inter = b + m[..., None]
        m_t = jnp.maximum(inter, jnp.max(dmat, axis=-1))
        w_inter = jnp.exp(inter - m_t)
        s = jnp.einsum('bhtd,bhsd->bhts', qc, kc) * jnp.exp(dmat - m_t[..., None])
        num = (w_inter[..., None] * jnp.einsum('bhtd,bhde->bhte', qc, cmat)
               + jnp.einsum('bhts,bhse->bhte', s, vc))
        den = w_inter * jnp.einsum('bhtd,bhd->bht', qc, nvec) + jnp.sum(s, axis=-1)
        h_out = num / jnp.maximum(jnp.abs(den), jnp.exp(-m_t))[..., None]
        b_last = b[..., -1]
        wlog = b_last[..., None] - b + ic
        m_new = jnp.maximum(b_last + m, jnp.max(wlog, axis=-1))
        decay = jnp.exp(b_last + m - m_new)
        ws = jnp.exp(wlog - m_new[..., None])[..., None]
        cmat = decay[..., None, None] * cmat + jnp.einsum('bhsd,bhse->bhde', kc * ws, vc)
        nvec = decay[..., None] * nvec + jnp.sum(kc * ws, axis=2)
        return (cmat, nvec, m_new), h_out

    state, hs = lax.scan(step, state, tuple(to_chunks(t) for t in (q, k, v, logf, logi)))
    return from_chunks(hs), state


def hgrn_scan(q, k, v, g, state):
    mask = jnp.tril(jnp.ones((CHUNK, CHUNK), dtype=bool))[:, :, None]

    def step(s_mat, xs):
        qc, kc, vc, gc = xs
        b = jnp.cumsum(gc, axis=2)
        diff = jnp.where(mask, b[:, :, :, None, :] - b[:, :, None, :, :], -jnp.inf)
        att = jnp.sum(qc[:, :, :, None, :] * kc[:, :, None, :, :] * jnp.exp(diff), axis=-1)
        o = (jnp.einsum('bhtd,bhde->bhte', qc * jnp.exp(b), s_mat)
             + jnp.einsum('bhts,bhse->bhte', att, vc))
        b_last = b[:, :, -1:, :]
        s_mat = (jnp.exp(b_last[:, :, 0, :, None]) * s_mat
                 + jnp.einsum('bhsd,bhse->bhde', kc * jnp.exp(b_last - b), vc))
        return s_mat, o

    state, os_ = lax.scan(step, state, tuple(to_chunks(t) for t in (q, k, v, g)))
    return from_chunks(os_), state


def rglru_scan(a, bx, h0):
    bx = bx.at[:, 0].add(a[:, 0] * h0)

    def combine(e1, e2):
        a1, b1 = e1
        a2, b2 = e2
        return a1 * a2, a2 * b1 + b2

    _, hs = lax.associative_scan(combine, (a, bx), axis=1)
    return hs, hs[:, -1]


def run_bidir(scan_fn, axis, init, ctx_f, lat_f, ctx_b, lat_b):
    flip = lambda t: jnp.flip(t, axis)
    oc_f, s_f = scan_fn(*ctx_f, init)
    ol_f, _ = scan_fn(*lat_f, s_f)
    oc_b, s_b = scan_fn(*[flip(t) for t in ctx_b], init)
    ol_b, _ = scan_fn(*[flip(t) for t in lat_b], s_b)
    return oc_f + flip(oc_b), ol_f + flip(ol_b)


def token_mixers(xn_l, xn_c, rows, w_in_l, gate_b_l, lb_l, conv_w_l, conv_b_l, rgw_l, rgb_l,
                 lam_l, branch_w_l, w_out_l, need_ctx):
    f32 = jnp.float32
    nb = xn_l.shape[0]
    pl = jnp.split(xn_l @ w_in_l, IN_OFFSETS, axis=-1)
    pc = jnp.split(xn_c @ w_in_l, IN_OFFSETS, axis=-1)

    def mlstm_inputs(p):
        bsz, s = p[0].shape[:2]
        q = to_heads(p[0], A_HEADS)
        k = to_heads(p[1], A_HEADS) * (A_DH ** -0.5)
        v = to_heads(p[2], A_HEADS)
        g = p[4].astype(f32).reshape(bsz, s, 2, 2, A_HEADS) + gate_b_l
        g = g.transpose(2, 3, 0, 4, 1)
        return ((q, k, v, jax.nn.log_sigmoid(g[0, 1]), g[0, 0]),
                (q, k, v, jax.nn.log_sigmoid(g[1, 1]), g[1, 0]))

    (acf, acb), (alf, alb) = mlstm_inputs(pc), mlstm_inputs(pl)
    a_init = (jnp.zeros((nb, A_HEADS, A_DH, A_DH), f32), jnp.zeros((nb, A_HEADS, A_DH), f32),
              jnp.zeros((nb, A_HEADS), f32))
    hc_a, hl_a = run_bidir(mlstm_scan, 2, a_init, acf, alf, acb, alb)

    def mlstm_out(hsum, p):
        return (from_heads(head_rms(hsum)) * jax.nn.sigmoid(p[3].astype(f32))).astype(p[3].dtype)

    def hgrn_inputs(p):
        q = jax.nn.silu(to_heads(p[5], B_HEADS))
        v = to_heads(p[8], B_HEADS)
        dirs = []
        for d, fpre in enumerate((p[6], p[7])):
            f = lb_l[d] + (1 - lb_l[d]) * jax.nn.sigmoid(fpre.astype(f32))
            f = to_heads(f, B_HEADS)
            dirs.append((q, 1 - f, v, jnp.log(f)))
        return dirs

    (bcf, bcb), (blf, blb) = hgrn_inputs(pc), hgrn_inputs(pl)
    b_init = jnp.zeros((nb, B_HEADS, B_DK, B_DK), f32)
    hc_b, hl_b = run_bidir(hgrn_scan, 2, b_init, bcf, blf, bcb, blb)

    def hgrn_out(osum, p):
        return (from_heads(head_rms(osum)) * jax.nn.silu(p[9].astype(f32))).astype(p[9].dtype)

    def to_cols(t):
        b, s, ch = t.shape
        return t.reshape(b, rows, GRID_W, ch).transpose(0, 2, 1, 3).reshape(b, s, ch)

    def from_cols(t):
        b, s, ch = t.shape
        return t.reshape(b, GRID_W, rows, ch).transpose(0, 2, 1, 3).reshape(b, s, ch)

    def conv(t):
        y = lax.conv_general_dilated(t, conv_w_l[:, None, :], window_strides=(1,), padding=(CONV_PAD,),
                                     dimension_numbers=('NWC', 'WIO', 'NWC'), feature_group_count=C_W)
        return y + conv_b_l

    def rg_inputs(t):
        bsz, s, _ = t.shape
        tf = t.astype(f32)
        blk = tf.reshape(bsz, s, C_BLOCKS, C_DB)
        dirs = []
        for d in range(2):
            r = jax.nn.sigmoid(jnp.einsum('btni,nij->btnj', blk, rgw_l[d, 0]).reshape(bsz, s, C_W) + rgb_l[d, 0])
            i = jax.nn.sigmoid(jnp.einsum('btni,nij->btnj', blk, rgw_l[d, 1]).reshape(bsz, s, C_W) + rgb_l[d, 1])
            log_a = -RG_C * r * jax.nn.softplus(-lam_l[d].astype(f32))
            dirs.append((jnp.exp(log_a), jnp.sqrt(-jnp.expm1(2 * log_a)) * (i * tf)))
        return dirs

    (ccf, ccb), (clf, clb) = rg_inputs(conv(pc[10])), rg_inputs(conv(to_cols(pl[10])))
    hc_c, hl_c = run_bidir(rglru_scan, 1, jnp.zeros((nb, C_W), f32), ccf, clf, ccb, clb)

    def merge(ya, yb, yc, p):
        ga, gb, gc = jnp.split(jax.nn.sigmoid(p[12]), N_BRANCH, axis=-1)
        merged = ga * (ya @ branch_w_l[0]) + gb * (yb @ branch_w_l[1]) + gc * (yc @ branch_w_l[2])
        return merged @ w_out_l

    yc_l = (from_cols(hl_c) * jax.nn.gelu(pl[11].astype(f32))).astype(pl[11].dtype)
    y_lat = merge(mlstm_out(hl_a, pl), hgrn_out(hl_b, pl), yc_l, pl)
    y_ctx = None
    if need_ctx:
        yc_c = (hc_c * jax.nn.gelu(pc[11].astype(f32))).astype(pc[11].dtype)
        y_ctx = merge(mlstm_out(hc_a, pc), hgrn_out(hc_b, pc), yc_c, pc)
    return y_lat, y_ctx


def setup_inputs(seed: int = 0) -> dict:
    key = jax.random.key(seed)
    ks = jax.random.split(key, 24)
    f32 = jnp.float32
    nrm = lambda k, shape, s: jax.random.normal(k, shape, f32) * s
    x = nrm(ks[0], (BATCH, SEQ, D_MODEL), 1.0)
    c = nrm(ks[1], (BATCH, D_MODEL), 1.0)
    ctx = nrm(ks[2], (BATCH, CTX_LEN, D_MODEL), 1.0)
    c_ctx = nrm(ks[3], (D_MODEL,), 1.0)
    mod_w = nrm(ks[4], (DEPTH, D_MODEL, N_MOD * D_MODEL), 0.5 * D_MODEL ** -0.5)
    mod_b = nrm(ks[5], (DEPTH, N_MOD * D_MODEL), 0.02)
    norm_g = 1.0 + nrm(ks[6], (DEPTH, 3, D_MODEL), 0.02)
    ffn_w_in = nrm(ks[7], (DEPTH, 2, D_MODEL, 2 * D_FF), D_MODEL ** -0.5)
    ffn_w_out = nrm(ks[8], (DEPTH, 2, D_FF, D_MODEL), D_FF ** -0.5)
    w_in = nrm(ks[9], (DEPTH, D_MODEL, IN_WIDTH), D_MODEL ** -0.5)
    i_bias = nrm(ks[10], (DEPTH, 2, 1, A_HEADS), 0.1)
    f_bias = jnp.linspace(3.0, 6.0, A_HEADS, dtype=f32) + nrm(ks[11], (DEPTH, 2, 1, A_HEADS), 0.1)
    mlstm_gate_b = jnp.concatenate([i_bias, f_bias], axis=2)
    hgrn_lb_logits = nrm(ks[12], (DEPTH, 2, B_W), 0.1)
    conv_w = nrm(ks[13], (DEPTH, CONV_W, C_W), CONV_W ** -0.5)
    conv_b = nrm(ks[14], (DEPTH, C_W), 0.02)
    rg_gate_w = nrm(ks[15], (DEPTH, 2, 2, C_BLOCKS, C_DB, C_DB), C_DB ** -0.5)
    rg_gate_b = nrm(ks[16], (DEPTH, 2, 2, C_W), 0.02)
    u = jax.random.uniform(ks[17], (DEPTH, 2, C_W), f32, 0.9, 0.999)
    base = u ** (1.0 / RG_C)
    rg_lambda = jnp.log(base) - jnp.log1p(-base)
    branch_w = nrm(ks[18], (DEPTH, N_BRANCH, A_W, D_MODEL), A_W ** -0.5)
    w_out = nrm(ks[19], (DEPTH, D_MODEL, D_MODEL), D_MODEL ** -0.5)
    final_g = 1.0 + nrm(ks[20], (D_MODEL,), 0.02)
    return {'x': x, 'c': c, 'ctx': ctx, 'c_ctx': c_ctx, 'mod_w': mod_w, 'mod_b': mod_b,
            'norm_g': norm_g, 'ffn_w_in': ffn_w_in, 'ffn_w_out': ffn_w_out, 'w_in': w_in,
            'mlstm_gate_b': mlstm_gate_b, 'hgrn_lb_logits': hgrn_lb_logits, 'conv_w': conv_w,
            'conv_b': conv_b, 'rg_gate_w': rg_gate_w, 'rg_gate_b': rg_gate_b, 'rg_lambda': rg_lambda,
            'branch_w': branch_w, 'w_out': w_out, 'final_g': final_g}


def reference(x, c, ctx, c_ctx, mod_w, mod_b, norm_g, ffn_w_in, ffn_w_out, w_in, mlstm_gate_b,
              hgrn_lb_logits, conv_w, conv_b, rg_gate_w, rg_gate_b, rg_lambda, branch_w, w_out, final_g):
    rows = x.shape[1] // GRID_W
    lb_p = jax.nn.softmax(hgrn_lb_logits.astype(jnp.float32), axis=0)
    lb_all = jnp.cumsum(lb_p, axis=0) - lb_p[0:1]
    sc = jax.nn.silu(c)[:, None, :]
    scc = jax.nn.silu(c_ctx)[None, None, :]
    h, hc = x, ctx
    for layer in range(DEPTH):
        last = layer == DEPTH - 1
        ml = jnp.split(sc @ mod_w[layer] + mod_b[layer], N_MOD, axis=-1)
        mc = jnp.split(scc @ mod_w[layer] + mod_b[layer], N_MOD, axis=-1)
        h = h + 0.5 * ml[2] * swiglu(adaln(h, norm_g[layer, 0], ml[0], ml[1]), ffn_w_in[layer, 0], ffn_w_out[layer, 0])
        hc = hc + 0.5 * mc[2] * swiglu(adaln(hc, norm_g[layer, 0], mc[0], mc[1]), ffn_w_in[layer, 0], ffn_w_out[layer, 0])
        y_lat, y_ctx = token_mixers(adaln(h, norm_g[layer, 1], ml[3], ml[4]), adaln(hc, norm_g[layer, 1], mc[3], mc[4]),
                                    rows, w_in[layer], mlstm_gate_b[layer], lb_all[layer], conv_w[layer],
                                    conv_b[layer], rg_gate_w[layer], rg_gate_b[layer], rg_lambda[layer],
                                    branch_w[layer], w_out[layer], not last)
        h = h + ml[5] * y_lat
        h = h + 0.5 * ml[8] * swiglu(adaln(h, norm_g[layer, 2], ml[6], ml[7]), ffn_w_in[layer, 1], ffn_w_out[layer, 1])
        if not last:
            hc = hc + mc[5] * y_ctx
            hc = hc + 0.5 * mc[8] * swiglu(adaln(hc, norm_g[layer, 2], mc[6], mc[7]), ffn_w_in[layer, 1], ffn_w_out[layer, 1])
    return rmsnorm(h, final_g)
```

```cpp
#include <hip/hip_runtime.h>
#include <cstdio>
#include <cstdint>
__device__ __forceinline__ int opaque_tid() { int t = threadIdx.x; asm volatile("" : "+v"(t)); return t; }
namespace pg8 {
#define PG8_LAS __attribute__((address_space(3)))
typedef unsigned short bf16_t;
typedef short bf16x8 __attribute__((ext_vector_type(8)));
typedef float f32x4 __attribute__((ext_vector_type(4)));
typedef unsigned u32x4 __attribute__((ext_vector_type(4)));
constexpr int BM = 256, BK = 64, HALF = 128, HTB = HALF * BK * 2  , STAGE_BYTES = 8 * HTB, NXCD = 8, WGM = 4;

__host__ __device__ __forceinline__ int lds_byte(int r, int c) { const int st = (r >> 4) * 2 + (c >> 5), rr = r & 15, cc = c & 31, ob = rr * 64 + cc * 2; return st * 1024 + (ob ^ (((ob >> 9) & 1) << 5)); }
__host__ __device__ __forceinline__ void stage_rc(int b, int& R, int& C) { const int st = b / 1024, sb = b % 1024, swz = sb ^ (((sb >> 9) & 1) << 5); R = (st >> 1) * 16 + swz / 64; C = (st & 1) * 32 + (swz % 64) / 2; }
__host__ __device__ __forceinline__ int perm32(int rho) { const int n = rho >> 4, i = rho & 15; return 8 * (i >> 2) + 4 * n + (i & 3); }

struct Unit { int pm, pn; };
struct Gemm { const bf16_t* A; const bf16_t* Bt; int M, N, K, lda, ldb; };

struct StaticOrder {
    int nN, np, x, slot, skip;
    __host__ __device__ void init(int M, int N, int G_, int c_, int skip_ = 0) { (void)M; (void)G_; nN = N / BM; skip = skip_ ? 1 : 0; np = 17 - skip; x = c_ & 7; slot = c_ >> 3; }
    __host__ __device__ bool next(int i, Unit& u) const {
        const int lid = i * 32 + slot; if (lid >= np * nN) return false;
        const int g4 = WGM * nN; int g = lid / g4; g = g > 3 ? 3 : g; const int rem = lid - g * g4, gsz = g == 3 ? np - 12 : 4;
        u.pm = 17 * x + skip + 4 * g + rem % gsz; u.pn = rem / gsz; return true;
    }
    __device__ __forceinline__ void a_ready(const Unit&) const {}
    __device__ __forceinline__ void done(const Unit&) const {}
};
template <class Epi, class Sched, bool ALIGN_EPI = false, bool SP2 = false>
__device__ __forceinline__ void gemm_phase(PG8_LAS unsigned char* lds, const Gemm g, const Sched& S, const Epi& E) {
    const int tid = opaque_tid(), wid = __builtin_amdgcn_readfirstlane(tid >> 6), lane = tid & 63, wr = wid >> 2, wc = wid & 3, fr = lane & 15, fq = lane >> 4;
    const int K = g.K, nt = K / BK;
    unsigned voffA[2], voffB[2];
#pragma unroll
    for (int i = 0; i < 2; ++i) { int R, C; stage_rc(tid * 16 + i * 8192, R, C); const int Rb = Epi::PERM ? ((R & ~31) + perm32(R & 31)) : R;
        voffA[i] = (unsigned)(R * g.lda + C) * 2u; voffB[i] = (unsigned)(Rb * g.ldb + C) * 2u; }
    const size_t kstep = (size_t)(BK * 2);
    const size_t hstepA = (size_t)HALF * g.lda * 2, hstepB = (size_t)HALF * g.ldb * 2;
    const size_t tstepA = 2 * hstepA, tstepB = 2 * hstepB;
    const unsigned ldsw = (unsigned)wid * 1024u;
    const int aoff = lds_byte(wr * 64 + fr, fq * 8), boff = lds_byte(wc * 32 + fr, fq * 8);
#define PG8_SA(b, h) (((b) * 2 + (h)) * HTB)
#define PG8_SB(b, h) ((4 + (b) * 2 + (h)) * HTB)
#define PG8_STAGE(bufoff, gbase, voff) do { _Pragma("unroll") for (int _i = 0; _i < 2; ++_i) \
        __builtin_amdgcn_global_load_lds((const unsigned*)((const char*)(gbase) + (voff)[_i]), (PG8_LAS unsigned*)(lds + (bufoff) + ldsw + _i * 8192), 16, 0, 0); } while (0)
#define PG8_LDA(dst, b, h) do { _Pragma("unroll") for (int m = 0; m < 4; ++m) _Pragma("unroll") for (int k = 0; k < 2; ++k) dst[m][k] = *(const PG8_LAS bf16x8*)(lds + PG8_SA(b, h) + aoff + m * 2048 + k * 1024); } while (0)
#define PG8_LDB(dst, b, h) do { _Pragma("unroll") for (int n = 0; n < 2; ++n) _Pragma("unroll") for (int k = 0; k < 2; ++k) dst[n][k] = *(const PG8_LAS bf16x8*)(lds + PG8_SB(b, h) + boff + n * 2048 + k * 1024); } while (0)
#define PG8_MMA(ai, bj, At, Bt) do { __builtin_amdgcn_s_setprio(1); _Pragma("unroll") for (int m = 0; m < 4; ++m) _Pragma("unroll") for (int n = 0; n < 2; ++n) _Pragma("unroll") for (int k = 0; k < 2; ++k) \
        acc[ai][bj][m][n] = __builtin_amdgcn_mfma_f32_16x16x32_bf16(Bt[n][k], At[m][k], acc[ai][bj][m][n], 0, 0, 0); __builtin_amdgcn_s_setprio(0); } while (0)
#define PG8_WAIT_V(n) asm volatile("s_waitcnt vmcnt(" #n ")" ::: "memory")
#define PG8_WAIT_L(n) asm volatile("s_waitcnt lgkmcnt(" #n ")" ::: "memory")
#define PG8_BAR __builtin_amdgcn_s_barrier()
#define PG8_SCHED __builtin_amdgcn_sched_barrier(0)
    Unit cur, nxt; int ui = 0;
    if (!S.next(0, cur)) return;
    f32x4 acc[2][2][4][2];
#pragma unroll
    for (int a = 0; a < 2; ++a)
#pragma unroll
        for (int b = 0; b < 2; ++b)
#pragma unroll
            for (int m = 0; m < 4; ++m)
#pragma unroll
                for (int n = 0; n < 2; ++n) acc[a][b][m][n] = (f32x4){0.f, 0.f, 0.f, 0.f};
    bf16x8 At[4][2], B0[2][2], B1[2][2];
    const char* cA = (const char*)g.A + (size_t)cur.pm * tstepA; const char* cB = (const char*)g.Bt + (size_t)cur.pn * tstepB;
    S.a_ready(cur);
    if constexpr (SP2) {
        PG8_STAGE(PG8_SB(0, 0), cB, voffB); PG8_STAGE(PG8_SB(0, 1), cB + hstepB, voffB); PG8_STAGE(PG8_SA(0, 0), cA, voffA); PG8_STAGE(PG8_SA(0, 1), cA + hstepA, voffA);
        if (wr == 1) PG8_BAR;
        PG8_WAIT_V(2); PG8_BAR;
        PG8_STAGE(PG8_SB(1, 0), cB + kstep, voffB); PG8_STAGE(PG8_SA(1, 0), cA + kstep, voffA); PG8_STAGE(PG8_SB(1, 1), cB + hstepB + kstep, voffB);
        PG8_WAIT_V(6); PG8_BAR;
    } else {
        PG8_STAGE(PG8_SB(0, 0), cB, voffB); PG8_STAGE(PG8_SA(0, 0), cA, voffA); PG8_STAGE(PG8_SB(0, 1), cB + hstepB, voffB); PG8_STAGE(PG8_SA(0, 1), cA + hstepA, voffA);
        if (wr == 1) PG8_BAR;
        PG8_WAIT_V(4); PG8_BAR;
        PG8_STAGE(PG8_SB(1, 0), cB + kstep, voffB); PG8_STAGE(PG8_SA(1, 0), cA + kstep, voffA); PG8_STAGE(PG8_SB(1, 1), cB + hstepB + kstep, voffB);
        PG8_WAIT_V(6); PG8_BAR;
    }
    for (;;) {
        const bool has_next = S.next(ui + 1, nxt);
        const char* nA = has_next ? (const char*)g.A + (size_t)nxt.pm * tstepA : cA; const char* nB = has_next ? (const char*)g.Bt + (size_t)nxt.pn * tstepB : cB;
        for (int t = 0; t < nt; t += 2) {
            const bool last = (t == nt - 2);
            const char* a1 = cA + (size_t)(t + 1) * kstep;
            const char* a2 = last ? nA : cA + (size_t)(t + 2) * kstep; const char* b2 = last ? nB : cB + (size_t)(t + 2) * kstep;
            const char* a3 = a2 + kstep; const char* b3 = b2 + kstep;
            if (last && has_next) S.a_ready(nxt);
            if constexpr (SP2) {
            PG8_LDB(B0, 0, 0); PG8_LDB(B1, 0, 1); PG8_SCHED; PG8_LDA(At, 0, 0); PG8_STAGE(PG8_SA(1, 1), a1 + hstepA, voffA);
            PG8_WAIT_V(8); PG8_WAIT_L(0); PG8_BAR; PG8_MMA(0, 0, At, B0); PG8_MMA(0, 1, At, B1); PG8_BAR; PG8_SCHED;
            PG8_LDA(At, 0, 1); PG8_STAGE(PG8_SB(0, 0), b2, voffB); PG8_STAGE(PG8_SB(0, 1), b2 + hstepB, voffB); PG8_STAGE(PG8_SA(0, 0), a2, voffA);
            PG8_WAIT_V(8); PG8_WAIT_L(0); PG8_BAR; PG8_MMA(1, 0, At, B0); PG8_MMA(1, 1, At, B1); PG8_BAR; PG8_SCHED;
            PG8_LDB(B0, 1, 0); PG8_LDB(B1, 1, 1); PG8_SCHED; PG8_LDA(At, 1, 0); PG8_STAGE(PG8_SA(0, 1), a2 + hstepA, voffA);
            PG8_WAIT_V(8); PG8_WAIT_L(0); PG8_BAR; PG8_MMA(0, 0, At, B0); PG8_MMA(0, 1, At, B1); PG8_BAR; PG8_SCHED;
            PG8_LDA(At, 1, 1); PG8_STAGE(PG8_SB(1, 0), b3, voffB); PG8_STAGE(PG8_SB(1, 1), b3 + hstepB, voffB); PG8_STAGE(PG8_SA(1, 0), a3, voffA);
            PG8_WAIT_V(8); PG8_WAIT_L(0); PG8_BAR; PG8_MMA(1, 0, At, B0); PG8_MMA(1, 1, At, B1); PG8_BAR; PG8_SCHED;
            if constexpr (Epi::HOOK) { if (t + 2 == Epi::HOOK_T0 || t + 2 == Epi::HOOK_T1) E.hook(acc, cur, t + 2, wr, wc, fr, fq); }
            } else {
            PG8_LDB(B0, 0, 0); PG8_SCHED; PG8_LDA(At, 0, 0); PG8_STAGE(PG8_SA(1, 1), a1 + hstepA, voffA);
            PG8_WAIT_L(8); PG8_BAR; PG8_WAIT_L(0); PG8_MMA(0, 0, At, B0); PG8_BAR; PG8_SCHED;
            PG8_LDB(B1, 0, 1); PG8_STAGE(PG8_SB(0, 0), b2, voffB);
            PG8_BAR; PG8_WAIT_L(0); PG8_MMA(0, 1, At, B1); PG8_BAR;
            PG8_LDA(At, 0, 1); PG8_STAGE(PG8_SA(0, 0), a2, voffA);
            PG8_BAR; PG8_WAIT_L(0); PG8_MMA(1, 0, At, B0); PG8_BAR; PG8_SCHED;
            PG8_STAGE(PG8_SB(0, 1), b2 + hstepB, voffB);
            PG8_WAIT_V(6); PG8_BAR; PG8_MMA(1, 1, At, B1); PG8_BAR;
            PG8_LDB(B0, 1, 0); PG8_SCHED; PG8_LDA(At, 1, 0); PG8_STAGE(PG8_SA(0, 1), a2 + hstepA, voffA);
            PG8_WAIT_L(8); PG8_BAR; PG8_WAIT_L(0); PG8_MMA(0, 0, At, B0); PG8_BAR; PG8_SCHED;
            PG8_LDB(B1, 1, 1); PG8_STAGE(PG8_SB(1, 0), b3, voffB);
            PG8_BAR; PG8_WAIT_L(0); PG8_MMA(0, 1, At, B1); PG8_BAR;
            PG8_LDA(At, 1, 1); PG8_STAGE(PG8_SA(1, 0), a3, voffA);
            PG8_BAR; PG8_WAIT_L(0); PG8_MMA(1, 0, At, B0); PG8_BAR; PG8_SCHED;
            PG8_STAGE(PG8_SB(1, 1), b3 + hstepB, voffB);
            PG8_WAIT_V(6); PG8_BAR; PG8_MMA(1, 1, At, B1); PG8_BAR;
            }
        }
        if constexpr (ALIGN_EPI) { if (wr == 0) PG8_BAR; }
        if constexpr (!Epi::AFTER_DRAIN) { E(acc, cur, wr, wc, fr, fq); S.done(cur); }
        if (!has_next) break;
#pragma unroll
        for (int a = 0; a < 2; ++a)
#pragma unroll
            for (int b = 0; b < 2; ++b)
#pragma unroll
                for (int m = 0; m < 4; ++m)
#pragma unroll
                    for (int n = 0; n < 2; ++n) acc[a][b][m][n] = (f32x4){0.f, 0.f, 0.f, 0.f};
        cur = nxt; cA = nA; cB = nB; ++ui;
        if constexpr (ALIGN_EPI) { if (wr == 1) PG8_BAR; }
    }
    PG8_WAIT_V(0);
    if constexpr (!ALIGN_EPI) { if (wr == 0) PG8_BAR; }
    PG8_BAR;
    if constexpr (Epi::AFTER_DRAIN) { E.fused(acc, cur, wr, wc, fr, fq, lds, wid, lane); S.done(cur); }
#undef PG8_SA
#undef PG8_SB
#undef PG8_STAGE
#undef PG8_LDA
#undef PG8_LDB
#undef PG8_MMA
#undef PG8_WAIT_V
#undef PG8_WAIT_L
#undef PG8_BAR
#undef PG8_SCHED
}
}

constexpr int D = 2048, NB = 8, SEQ = 4096, CTXL = 256, TOK = SEQ + CTXL, M = NB * TOK, DFF = 5632, NL = 4, NMOD = 9, MODW = NMOD * D;
constexpr int INW = 17424, INP = 17664;
constexpr int PA_LD = 4096, PB_LD = 5120, PC_LD = 2048, PG_LD = 6144;
constexpr float EPS = 1e-6f;
constexpr size_t MiB = 1u << 20;
constexpr size_t WS_CTL = 0, CTL_ZERO_BYTES = MiB;
constexpr size_t WS_MODS = 1 * MiB, WS_LB = 4 * MiB, WS_W1T = 5 * MiB, WS_W2T = 93 * MiB, WS_WINT = 137 * MiB, WS_WBRT = 206 * MiB, WS_WOT = 218 * MiB,
                 WS_HC = 226 * MiB, WS_GT = 242 * MiB, WS_XN = 245 * MiB, WS_PA = 381 * MiB, WS_PB = 653 * MiB, WS_PC = 993 * MiB, WS_PG = 1129 * MiB,
                 WS_SO = 1537 * MiB, WS_GTB = 1945 * MiB, WS_Y = 1962 * MiB, WS_WSET2 = 2098 * MiB, WS_Y3 = 2319 * MiB, WS_END = 2523 * MiB;
constexpr size_t SO_STRIDE = (size_t)M * 1024;
static_assert((size_t)M * DFF * 2 <= 6 * SO_STRIDE * 2, "hidden overlay");
constexpr int CW_BAR = 4096, CW_Q = 8192, CW_GBAR = 16384;
constexpr size_t WSET_STRIDE = WS_WSET2 - WS_W1T;
constexpr int RING_BYTES = 131072, LDSCTL_OFF = RING_BYTES, LDS_BYTES = 147456;

#define GAS __attribute__((address_space(1)))
#define LAS __attribute__((address_space(3)))
typedef unsigned short bf16;
typedef unsigned v4u __attribute__((ext_vector_type(4)));
typedef unsigned v2u __attribute__((ext_vector_type(2)));
typedef float f32x4 __attribute__((ext_vector_type(4)));
typedef float f32x2 __attribute__((ext_vector_type(2)));
using pg8::Unit;

typedef __bf16 bf16x2_t __attribute__((ext_vector_type(2)));
__device__ __forceinline__ unsigned cvt_pk_bf16(float lo, float hi) { f32x2 v = {lo, hi}; bf16x2_t r = __builtin_convertvector(v, bf16x2_t); return __builtin_bit_cast(unsigned, r); }
__device__ __forceinline__ float bflo(unsigned w) { return __uint_as_float(w << 16); }
__device__ __forceinline__ float bfhi(unsigned w) { return __uint_as_float(w & 0xffff0000u); }
__device__ __forceinline__ float bf1(bf16 b) { return __uint_as_float(((unsigned)b) << 16); }
__device__ __forceinline__ float sigmoid_f(float x) { return __builtin_amdgcn_rcpf(1.0f + __builtin_amdgcn_exp2f(-1.44269504f * x)); }
__device__ __forceinline__ float silu_f(float x) { return x * sigmoid_f(x); }
__device__ __forceinline__ float gelu_tanh_f(float x) { return x * sigmoid_f(1.5957691216f * (x + 0.044715f * x * x * x)); }
#define DPPF(old, src, ctrl, rmask) __int_as_float(__builtin_amdgcn_update_dpp(__float_as_int(old), __float_as_int(src), (ctrl), (rmask), 0xf, false))
__device__ __forceinline__ float wave_prefix_sum(float v) {
    v += DPPF(0.f, v, 0x111, 0xf); v += DPPF(0.f, v, 0x112, 0xf); v += DPPF(0.f, v, 0x114, 0xf); v += DPPF(0.f, v, 0x118, 0xf);
    v += DPPF(0.f, v, 0x142, 0xa); v += DPPF(0.f, v, 0x143, 0xc); return v; }
__device__ __forceinline__ float wave_prefix_max(float v) { const float ninf = -__builtin_inff();
    v = fmaxf(v, DPPF(ninf, v, 0x111, 0xf)); v = fmaxf(v, DPPF(ninf, v, 0x112, 0xf)); v = fmaxf(v, DPPF(ninf, v, 0x114, 0xf)); v = fmaxf(v, DPPF(ninf, v, 0x118, 0xf));
    v = fmaxf(v, DPPF(ninf, v, 0x142, 0xa)); v = fmaxf(v, DPPF(ninf, v, 0x143, 0xc)); return v; }
__device__ __forceinline__ float wave_sum(float v) { return __int_as_float(__builtin_amdgcn_readlane(__float_as_int(wave_prefix_sum(v)), 63)); }
__device__ __forceinline__ float group8_sum(float v) { v += DPPF(0.f, v, 0xB1, 0xf); v += DPPF(0.f, v, 0x4E, 0xf); v += DPPF(0.f, v, 0x141, 0xf); return v; }
__device__ __forceinline__ float group16_sum(float v) { v = group8_sum(v); v += DPPF(0.f, v, 0x140, 0xf); return v; }
__device__ __forceinline__ void unpack8(const v4u w, float (&f)[8]) { f[0] = bflo(w.x); f[1] = bfhi(w.x); f[2] = bflo(w.y); f[3] = bfhi(w.y); f[4] = bflo(w.z); f[5] = bfhi(w.z); f[6] = bflo(w.w); f[7] = bfhi(w.w); }
__device__ __forceinline__ v4u pack8(const float (&f)[8]) { v4u w; w.x = cvt_pk_bf16(f[0], f[1]); w.y = cvt_pk_bf16(f[2], f[3]); w.z = cvt_pk_bf16(f[4], f[5]); w.w = cvt_pk_bf16(f[6], f[7]); return w; }
#define LDS_WAIT() asm volatile("s_waitcnt lgkmcnt(0)" ::: "memory")
#define PH_IDS const int tid = opaque_tid(), lane = tid & 63, wave = __builtin_amdgcn_readfirstlane(tid >> 6), gw = blockIdx.x * 8 + wave, ngw = gridDim.x * 8; (void)gw; (void)ngw; (void)lane; (void)wave

#define XB_TMO      128
#define XB_XCNT(j)  (256  + 64 * (j))
#define XB_XSUB(j)  (1280 + 64 * (j))
#define XB_XGEN(j)  (2304 + 64 * (j))
#define XB_TOP      3328
#define XB_TOPGEN   3392
#define XCD_BAR_WORDS 3456
#define XB_SPIN_CAP (1u << 18)

__device__ __forceinline__ unsigned xb_ld(unsigned* p)              { return __hip_atomic_load(p, __ATOMIC_RELAXED, __HIP_MEMORY_SCOPE_AGENT); }
__device__ __forceinline__ unsigned xb_add(unsigned* p, unsigned v) { return __hip_atomic_fetch_add(p, v, __ATOMIC_RELAXED, __HIP_MEMORY_SCOPE_AGENT); }
__device__ __forceinline__ unsigned xb_xcc_id() { return (unsigned)__builtin_amdgcn_s_getreg((3 << 11) | 20) & 0xFu; }
#define XB_SPIN(cond, bar) do { unsigned _sp = 0; while (cond) { __builtin_amdgcn_s_sleep(1); \
    if ((++_sp & 255u) == 0u) { if (xb_ld(&(bar)[XB_TMO])) break; if (_sp > XB_SPIN_CAP) { atomicAdd(&(bar)[XB_TMO], 1u); break; } } } } while (0)

struct XcdBarrier {
    unsigned* bar; unsigned x;
    volatile LAS unsigned* st;
};

__device__ __forceinline__ XcdBarrier xcd_barrier_post(unsigned* bar, volatile LAS unsigned* st) {
    XcdBarrier b; b.bar = bar; b.x = xb_xcc_id(); b.st = st;
    if (threadIdx.x == 0) (void)xb_add(&bar[XB_XCNT(b.x)], 1u);
    return b;
}
__device__ __forceinline__ void xcd_barrier_complete(unsigned* bar, unsigned x, unsigned& nloc, unsigned& nx) {
    const unsigned G = gridDim.x * gridDim.y * gridDim.z;
    unsigned sum, cnt, mine, sp = 0u;
    for (;;) {
        sum = 0u; cnt = 0u; mine = 0u;
#pragma unroll
        for (unsigned j = 0; j < 16; ++j) { const unsigned c = xb_ld(&bar[XB_XCNT(j)]); sum += c; cnt += (c > 0u) ? 1u : 0u; mine = (j == x) ? c : mine; }
        if (sum == G) break;
        __builtin_amdgcn_s_sleep(1);
        if ((++sp & 255u) == 0u) { if (xb_ld(&bar[XB_TMO])) break; if (sp > XB_SPIN_CAP) { atomicAdd(&bar[XB_TMO], 1u); break; } }
    }
    nloc = mine > 0u ? mine : 1u; nx = cnt > 0u ? cnt : 1u;
}

__device__ __forceinline__ void xcd_barrier(const XcdBarrier& b) {
    asm volatile("s_waitcnt vmcnt(0)" ::: "memory");
    __syncthreads();
    if (threadIdx.x == 0) {
        unsigned* bar = b.bar;
        __builtin_amdgcn_s_waitcnt(0);
        unsigned nloc = b.st[0], nx = b.st[1];
        if (nloc == 0u) { xcd_barrier_complete(bar, b.x, nloc, nx); b.st[0] = nloc; b.st[1] = nx; }
        const unsigned old = xb_add(&bar[XB_XSUB(b.x)], 1u);
        const unsigned gen = old / nloc;
        if (old + 1u == (gen + 1u) * nloc) {
            __builtin_amdgcn_fence(__ATOMIC_RELEASE, "agent");
            asm volatile("s_waitcnt vmcnt(0)" ::: "memory");
            const unsigned og = xb_add(&bar[XB_TOP], 1u);
            const unsigned tg = og / nx;
            if (og + 1u == (tg + 1u) * nx) xb_add(&bar[XB_TOPGEN], 1u);
            else XB_SPIN(xb_ld(&bar[XB_TOPGEN]) == tg, bar);
            __builtin_amdgcn_fence(__ATOMIC_ACQUIRE, "agent");
            xb_add(&bar[XB_XGEN(b.x)], 1u);
            asm volatile("s_waitcnt vmcnt(0)" ::: "memory");
        } else {
            XB_SPIN(xb_ld(&bar[XB_XGEN(b.x)]) == gen, bar);
            __builtin_amdgcn_fence(__ATOMIC_ACQUIRE, "agent");
            asm volatile("s_waitcnt vmcnt(0)" ::: "memory");
        }
    }
    __syncthreads();
}

#define GB_CNT(c)    (64 * (c))
#define GB_SUB(c)    (8192 + 64 * (c))
#define GB_GEN(c)    (16384 + 64 * (c))
#define GB_TOP(g)    (24576 + 64 * (g))
#define GB_TOPGEN(g) (25088 + 64 * (g))
#define GRP_BAR_WORDS 25600
__device__ __forceinline__ void grp_barrier_post(unsigned* gb) { if (threadIdx.x == 0) (void)xb_add(&gb[GB_CNT(xb_xcc_id() * 8u + ((unsigned)blockIdx.x & 7u))], 1u); }
__device__ __forceinline__ void grp_barrier_census(unsigned* gb, volatile LAS unsigned* st) {
    if (threadIdx.x == 0) {
        const unsigned x = xb_xcc_id(), g = (unsigned)blockIdx.x & 7u; unsigned mine = 0u, cnt = 0u;
#pragma unroll
        for (unsigned j = 0; j < 16; ++j) { const unsigned c = xb_ld(&gb[GB_CNT(j * 8u + g)]); cnt += (c > 0u) ? 1u : 0u; mine = (j == x) ? c : mine; }
        st[2] = mine > 0u ? mine : 1u; st[3] = cnt > 0u ? cnt : 1u;
    }
}
__device__ __forceinline__ void grp_barrier(unsigned* gb, unsigned* bar, volatile LAS unsigned* st) {
    asm volatile("s_waitcnt vmcnt(0)" ::: "memory");
    __syncthreads();
    if (threadIdx.x == 0) {
        __builtin_amdgcn_s_waitcnt(0);
        const unsigned g = (unsigned)blockIdx.x & 7u, cell = xb_xcc_id() * 8u + g, nloc = st[2], nx = st[3];
        const unsigned old = xb_add(&gb[GB_SUB(cell)], 1u);
        const unsigned gen = old / nloc;
        if (old + 1u == (gen + 1u) * nloc) {
            if (nx > 1u) {
                __builtin_amdgcn_fence(__ATOMIC_RELEASE, "agent");
                asm volatile("s_waitcnt vmcnt(0)" ::: "memory");
                const unsigned og = xb_add(&gb[GB_TOP(g)], 1u);
                const unsigned tg = og / nx;
                if (og + 1u == (tg + 1u) * nx) xb_add(&gb[GB_TOPGEN(g)], 1u);
                else XB_SPIN(xb_ld(&gb[GB_TOPGEN(g)]) == tg, bar);
            }
            __builtin_amdgcn_fence(__ATOMIC_ACQUIRE, "agent");
            xb_add(&gb[GB_GEN(cell)], 1u);
            asm volatile("s_waitcnt vmcnt(0)" ::: "memory");
        } else {
            XB_SPIN(xb_ld(&gb[GB_GEN(cell)]) == gen, bar);
            __builtin_amdgcn_fence(__ATOMIC_ACQUIRE, "agent");
            asm volatile("s_waitcnt vmcnt(0)" ::: "memory");
        }
    }
    __syncthreads();
}

#define GB_SUBA(g)    (25600 + 64 * (g))
#define GB_SUBAGEN(g) (26112 + 64 * (g))
#define GB_SUBB(g)    (26624 + 64 * (g))
#define GB_SUBBGEN(g) (27136 + 64 * (g))
__device__ __forceinline__ void sub_barrier(unsigned* gb, unsigned* bar, unsigned cnt_word, unsigned gen_word, unsigned n) {
    asm volatile("s_waitcnt vmcnt(0)" ::: "memory");
    __syncthreads();
    if (threadIdx.x == 0) {
        __builtin_amdgcn_s_waitcnt(0);
        const unsigned old = xb_add(&gb[cnt_word], 1u), gen = old / n;
        if (old + 1u == (gen + 1u) * n) xb_add(&gb[gen_word], 1u);
        else XB_SPIN(xb_ld(&gb[gen_word]) == gen, bar);
        __builtin_amdgcn_fence(__ATOMIC_ACQUIRE, "agent");
        asm volatile("s_waitcnt vmcnt(0)" ::: "memory");
    }
    __syncthreads();
}

struct Args { const float* in[20]; float* out; unsigned char* ws; };
constexpr int TBL_OFF = LDSCTL_OFF + 256;
__device__ __forceinline__ unsigned long long tbl_get(LAS unsigned char* lds, int k) {
    unsigned off = TBL_OFF + 8 * k; asm volatile("" : "+s"(off));
    volatile LAS unsigned* p = (volatile LAS unsigned*)(lds + off); const unsigned lo = __builtin_amdgcn_readfirstlane(p[0]), hi = __builtin_amdgcn_readfirstlane(p[1]);
    return ((unsigned long long)hi << 32) | lo; }
__device__ __forceinline__ const float* inp(LAS unsigned char* lds, int k) { return (const float*)(GAS const float*)tbl_get(lds, k); }
__device__ __forceinline__ float* outp(LAS unsigned char* lds) { return (float*)(GAS float*)tbl_get(lds, 20); }
__device__ __forceinline__ unsigned char* wsp(LAS unsigned char* lds) { return (unsigned char*)(GAS unsigned char*)tbl_get(lds, 21); }

struct EpiStoreBf16 {
    static constexpr bool PERM = true, AFTER_DRAIN = false, HOOK = false; static constexpr int HOOK_T0 = -1, HOOK_T1 = -1;
    bf16* Y;
    __device__ __forceinline__ void operator()(const f32x4 (&acc)[2][2][4][2], const Unit& u, int wr, int wc, int fr, int fq) const {
        bf16* p0 = Y + (size_t)(u.pm * 256 + wr * 64 + fr) * D + u.pn * 256 + wc * 32 + 8 * fq;
#pragma unroll
        for (int ai = 0; ai < 2; ++ai)
#pragma unroll
            for (int m = 0; m < 4; ++m)
#pragma unroll
                for (int bj = 0; bj < 2; ++bj) { const f32x4 a0 = acc[ai][bj][m][0], a1 = acc[ai][bj][m][1]; v4u w;
                    w.x = cvt_pk_bf16(a0.x, a0.y); w.y = cvt_pk_bf16(a0.z, a0.w); w.z = cvt_pk_bf16(a1.x, a1.y); w.w = cvt_pk_bf16(a1.z, a1.w);
                    *(v4u*)(p0 + (size_t)(ai * 128 + m * 16) * D + bj * 128) = w; }
    }
};
struct EpiSwiGLU {
    static constexpr bool PERM = true, AFTER_DRAIN = false, HOOK = false; static constexpr int HOOK_T0 = -1, HOOK_T1 = -1;
    bf16* H;
    __device__ __forceinline__ void operator()(const f32x4 (&acc)[2][2][4][2], const Unit& u, int wr, int wc, int fr, int fq) const {
        const int row0 = u.pm * 256 + wr * 64 + fr, col0 = u.pn * 128 + wc * 32 + 8 * fq;
#pragma unroll
        for (int ai = 0; ai < 2; ++ai)
#pragma unroll
            for (int m = 0; m < 4; ++m) { float o[8];
#pragma unroll
                for (int n = 0; n < 2; ++n)
#pragma unroll
                    for (int q = 0; q < 4; ++q) o[4 * n + q] = silu_f(acc[ai][0][m][n][q]) * acc[ai][1][m][n][q];
                *(v4u*)(H + (size_t)(row0 + ai * 128 + m * 16) * DFF + col0) = pack8(o); }
    }
};
struct EpiInProj {
    static constexpr bool PERM = true, AFTER_DRAIN = false, HOOK = false; static constexpr int HOOK_T0 = -1, HOOK_T1 = -1;
    bf16 *PA, *PB, *PC, *PG, *GTB;
    template <int ACT> __device__ __forceinline__ void run(const f32x4 (&acc)[2][2][4][2], bf16* p0, int ld) const {
#pragma unroll
        for (int ai = 0; ai < 2; ++ai)
#pragma unroll
            for (int m = 0; m < 4; ++m) { bf16* rowp = p0 + (size_t)(ai * 128 + m * 16) * ld;
#pragma unroll
                for (int bj = 0; bj < 2; ++bj) { float o[8];
#pragma unroll
                    for (int n = 0; n < 2; ++n)
#pragma unroll
                        for (int q = 0; q < 4; ++q) { const float v = acc[ai][bj][m][n][q]; o[4 * n + q] = ACT == 0 ? v : ACT == 1 ? v * 0.0625f : ACT == 2 ? sigmoid_f(v) : ACT == 3 ? silu_f(v) : gelu_tanh_f(v); }
                    *(v4u*)(rowp + bj * 128) = pack8(o); }
                asm volatile("" ::: "memory"); }
    }
    __device__ __forceinline__ void operator()(const f32x4 (&acc)[2][2][4][2], const Unit& u, int wr, int wc, int fr, int fq) const {
        const int row0 = u.pm * 256 + wr * 64 + fr;
        const int seg = u.pn >> 2; bf16* base; int ld, cseg;
        if (seg < 4) { base = PA; ld = PA_LD; cseg = seg * 1024; } else if (seg < 9) { base = PB; ld = PB_LD; cseg = (seg - 4) * 1024; }
        else if (seg < 11) { base = PC; ld = PC_LD; cseg = (seg - 9) * 1024; } else if (seg < 17) { base = PG; ld = PG_LD; cseg = (seg - 11) * 1024; } else { base = GTB; ld = 256; cseg = 0; }
        const int act = (seg == 1) ? 1 : (seg == 3 || (seg >= 11 && seg < 17)) ? 2 : (seg == 4 || seg == 8) ? 3 : (seg == 10) ? 4 : 0;
        bf16* p0 = base + (size_t)row0 * ld + cseg + (u.pn & 3) * 256 + wc * 32 + 8 * fq;
        if (act == 0) run<0>(acc, p0, ld); else if (act == 1) run<1>(acc, p0, ld); else if (act == 2) run<2>(acc, p0, ld); else if (act == 3) run<3>(acc, p0, ld); else run<4>(acc, p0, ld);
    }
};
struct EpiBranch {
    static constexpr bool PERM = true, AFTER_DRAIN = false, HOOK = false; static constexpr int HOOK_T0 = -1, HOOK_T1 = -1;
    const bf16* PG; bf16* MG; int br;
    __device__ __forceinline__ void operator()(const f32x4 (&acc)[2][2][4][2], const Unit& u, int wr, int wc, int fr, int fq) const {
        const size_t r0 = (size_t)(u.pm * 256 + wr * 64 + fr); const int col0 = u.pn * 256 + wc * 32 + 8 * fq;
        const bf16* gp0 = PG + r0 * PG_LD + br * 2048 + col0; bf16* mp0 = MG + r0 * D + col0;
#pragma unroll
        for (int ai = 0; ai < 2; ++ai) { v4u gw[4][2], ow[4][2];
#pragma unroll
            for (int m = 0; m < 4; ++m)
#pragma unroll
                for (int bj = 0; bj < 2; ++bj) { const size_t ro = (size_t)(ai * 128 + m * 16); gw[m][bj] = *(const v4u*)(gp0 + ro * PG_LD + bj * 128); ow[m][bj] = (v4u){0u, 0u, 0u, 0u};
                    if (br > 0) ow[m][bj] = *(const v4u*)(mp0 + ro * D + bj * 128); }
#pragma unroll
            for (int m = 0; m < 4; ++m)
#pragma unroll
                for (int bj = 0; bj < 2; ++bj) { const size_t ro = (size_t)(ai * 128 + m * 16); const v4u g = gw[m][bj], o = ow[m][bj]; const f32x4 a0 = acc[ai][bj][m][0], a1 = acc[ai][bj][m][1]; v4u w;
                    w.x = cvt_pk_bf16(bflo(o.x) + bflo(g.x) * a0.x, bfhi(o.x) + bfhi(g.x) * a0.y); w.y = cvt_pk_bf16(bflo(o.y) + bflo(g.y) * a0.z, bfhi(o.y) + bfhi(g.y) * a0.w);
                    w.z = cvt_pk_bf16(bflo(o.z) + bflo(g.z) * a1.x, bfhi(o.z) + bfhi(g.z) * a1.y); w.w = cvt_pk_bf16(bflo(o.w) + bflo(g.w) * a1.z, bfhi(o.w) + bfhi(g.w) * a1.w);
                    *(v4u*)(mp0 + ro * D + bj * 128) = w; }
            asm volatile("" ::: "memory"); }
    }
};

__device__ __forceinline__ void phase_mods(LAS unsigned char* lds, int l0, int l1, int first, int stride, bool do_lb) {
    PH_IDS;
    LAS float* sc = (LAS float*)lds;
    LAS float* red = (LAS float*)(lds + 73728);
    const float* c = inp(lds, 1); const float* cctx = inp(lds, 3); const float* mod_w = inp(lds, 4); const float* mod_b = inp(lds, 5);
    float* mods = (float*)(wsp(lds) + WS_MODS);
    for (int i = tid; i < 9 * 2048; i += 512) { const int mi = i >> 11, k = i & 2047; const float v = mi < 8 ? c[mi * 2048 + k] : cctx[k]; sc[i] = silu_f(v); }
    __syncthreads();
    for (int item = first; item < (l1 - l0) * 144; item += stride) {
        const int l = l0 + item / 144, cb = item % 144; const int col = cb * 128 + 2 * lane;
        const float* wp = mod_w + (size_t)l * D * MODW + (size_t)(wave * 256) * MODW + col;
        float acc[9][2];
#pragma unroll
        for (int mi = 0; mi < 9; ++mi) { acc[mi][0] = 0.f; acc[mi][1] = 0.f; }
        for (int k = 0; k < 256; k += 8) {
            f32x2 wv[8];
#pragma unroll
            for (int u = 0; u < 8; ++u) wv[u] = *(const f32x2*)(wp + (size_t)(k + u) * MODW);
#pragma unroll
            for (int u = 0; u < 8; ++u)
#pragma unroll
                for (int mi = 0; mi < 9; ++mi) { const float s = sc[mi * 2048 + wave * 256 + k + u]; acc[mi][0] += s * wv[u].x; acc[mi][1] += s * wv[u].y; }
        }
#pragma unroll
        for (int mi = 0; mi < 9; ++mi) { red[(wave * 9 + mi) * 128 + 2 * lane] = acc[mi][0]; red[(wave * 9 + mi) * 128 + 2 * lane + 1] = acc[mi][1]; }
        __syncthreads();
        for (int o = tid; o < 9 * 128; o += 512) { const int mi = o >> 7, cc = o & 127; float s = 0.f;
#pragma unroll
            for (int w = 0; w < 8; ++w) s += red[(w * 9 + mi) * 128 + cc];
            mods[((size_t)l * 9 + mi) * MODW + cb * 128 + cc] = s + mod_b[(size_t)l * MODW + cb * 128 + cc]; }
        __syncthreads();
    }
    float* LB = (float*)(wsp(lds) + WS_LB); const float* lg = inp(lds, 11);
    if (do_lb) for (int i = blockIdx.x * 512 + tid; i < 2048; i += gridDim.x * 512) {
        const float x0 = lg[i], x1 = lg[2048 + i], x2 = lg[4096 + i], x3 = lg[6144 + i];
        const float mx = fmaxf(fmaxf(x0, x1), fmaxf(x2, x3));
        const float e0 = expf(x0 - mx), e1 = expf(x1 - mx), e2 = expf(x2 - mx), e3 = expf(x3 - mx), inv = 1.0f / (e0 + e1 + e2 + e3);
        LB[i] = 0.f; LB[2048 + i] = e1 * inv; LB[4096 + i] = (e1 + e2) * inv; LB[6144 + i] = (e1 + e2 + e3) * inv;
    }
}

__device__ __forceinline__ int srccol(int map, int nd) {
    if (map == 0) return nd;
    if (map == 1) { const int t = nd >> 8, w = nd & 255; return w < 128 ? 128 * t + w : 5632 + 128 * t + (w - 128); }
    return nd < 4096 ? nd : nd < 17408 ? nd + 16 : nd < 17424 ? 4096 + (nd - 17408) : -1;
}
__device__ __forceinline__ void transpose_item(const float* W, int N, int ldk, bf16* WT, int nblk, int idx, int map, LAS float* scr, int lane) {
    const int kb = idx / nblk, nb = idx - kb * nblk, k0 = 64 * kb, n0 = 32 * nb;
    const int sc = srccol(map, n0 + (lane & 31));
    float wv[32];
#pragma unroll
    for (int i = 0; i < 32; ++i) wv[i] = sc >= 0 ? W[(size_t)(k0 + 2 * i + (lane >> 5)) * N + sc] : 0.f;
#pragma unroll
    for (int i = 0; i < 32; ++i) scr[(2 * i + (lane >> 5)) * 33 + (lane & 31)] = wv[i];
    LDS_WAIT(); asm volatile("" ::: "memory");
    const int c = lane & 7;
#pragma unroll
    for (int j = 0; j < 4; ++j) { const int n = (lane >> 3) + 8 * j; const LAS float* s = scr + (8 * c) * 33 + n;
        v4u o; o.x = cvt_pk_bf16(s[0 * 33], s[1 * 33]); o.y = cvt_pk_bf16(s[2 * 33], s[3 * 33]); o.z = cvt_pk_bf16(s[4 * 33], s[5 * 33]); o.w = cvt_pk_bf16(s[6 * 33], s[7 * 33]);
        *(v4u*)(WT + (size_t)(n0 + n) * ldk + k0 + 8 * c) = o; }
    LDS_WAIT(); asm volatile("" ::: "memory");
}
constexpr int CV_W1 = 32 * 352, CV_W2 = 88 * 64, CV_WIN = 32 * 552, CV_BR = 16 * 64, CV_WO = 32 * 64, CV_NITEMS = 2 * CV_W1 + 2 * CV_W2 + CV_WIN + 3 * CV_BR + CV_WO;
__device__ __forceinline__ void convert_item(int l, int it, LAS unsigned char* lds, LAS float* scr, int lane) {
    unsigned char* wb = wsp(lds) + (size_t)(l & 1) * WSET_STRIDE;
    bf16* W1T = (bf16*)(wb + WS_W1T); bf16* W2T = (bf16*)(wb + WS_W2T); bf16* WINT = (bf16*)(wb + WS_WINT); bf16* WBRT = (bf16*)(wb + WS_WBRT); bf16* WOT = (bf16*)(wb + WS_WOT);
    int r = it;
    if (r < 2 * CV_W1) { const int s = r / CV_W1; r -= s * CV_W1; transpose_item(inp(lds, 7) + (size_t)(l * 2 + s) * D * (2 * DFF), 2 * DFF, D, W1T + (size_t)s * (2 * DFF) * D, 352, r, 1, scr, lane); return; } r -= 2 * CV_W1;
    if (r < 2 * CV_W2) { const int s = r / CV_W2; r -= s * CV_W2; transpose_item(inp(lds, 8) + (size_t)(l * 2 + s) * DFF * D, D, DFF, W2T + (size_t)s * D * DFF, 64, r, 0, scr, lane); return; } r -= 2 * CV_W2;
    if (r < CV_WIN) { transpose_item(inp(lds, 9) + (size_t)l * D * INW, INW, D, WINT, 552, r, 2, scr, lane); return; } r -= CV_WIN;
    if (r < 3 * CV_BR) { const int s = r / CV_BR; r -= s * CV_BR; transpose_item(inp(lds, 17) + (size_t)(l * 3 + s) * 1024 * D, D, 3072, WBRT + (size_t)s * 1024, 64, r, 0, scr, lane); return; } r -= 3 * CV_BR;
    transpose_item(inp(lds, 18) + (size_t)l * D * D, D, D, WOT, 64, r, 0, scr, lane);
}
__device__ __forceinline__ void convert_in_tail(int l, int h, LAS unsigned char* lds) {
    PH_IDS;
    LAS float* scr = (LAS float*)(lds + wave * 16384);
    const int lo = h * (CV_NITEMS / 2), hi = lo + CV_NITEMS / 2;
    for (int it = lo + ((int)blockIdx.x - 96) * 8 + wave; it < hi; it += 160 * 8) convert_item(l, it, lds, scr, lane);
}
__device__ __forceinline__ void phase_convert(int l, LAS unsigned char* lds) {
    PH_IDS;
    LAS float* scr = (LAS float*)(lds + wave * 16384);
    for (int it = gw; it < CV_NITEMS; it += ngw) convert_item(l, it, lds, scr, lane);
}
struct NormArgs { const float* lat_src; const float* ctx_src; float* lat_dst; float* ctx_dst; const bf16* Y; const float* gate; float coef; const float* g; const float* shift; bf16* XN; float* fin_out; };
__device__ __forceinline__ void norm_one_row(const NormArgs& na, int r, int lane) {
    const int b = r / TOK, t = r - b * TOK; const bool isctx = t < CTXL; const int mi = isctx ? 8 : b;
    if (na.fin_out && isctx) return;
    const size_t ho = isctx ? ((size_t)b * CTXL + t) * D : ((size_t)b * SEQ + (t - CTXL)) * D;
    const float* src = (isctx ? na.ctx_src : na.lat_src) + ho;
    f32x4 v[8], gt[8]; v2u yw[8];
#pragma unroll
    for (int j = 0; j < 8; ++j) v[j] = __builtin_nontemporal_load((const f32x4*)src + lane + 64 * j);
    if (na.Y) { const float* gp = na.gate + (size_t)mi * MODW;
#pragma unroll
        for (int j = 0; j < 8; ++j) { const int c = 4 * lane + 256 * j; yw[j] = __builtin_nontemporal_load((const v2u*)(na.Y + (size_t)r * D + c)); gt[j] = *(const f32x4*)(gp + c); } }
    __builtin_amdgcn_sched_barrier(0);
    if (na.Y) {
#pragma unroll
        for (int j = 0; j < 8; ++j) v[j] += (f32x4){bflo(yw[j].x), bfhi(yw[j].x), bflo(yw[j].y), bfhi(yw[j].y)} * gt[j] * na.coef;
        if (!na.fin_out) { float* dst = (isctx ? na.ctx_dst : na.lat_dst) + ho;
#pragma unroll
            for (int j = 0; j < 8; ++j) __builtin_nontemporal_store(v[j], (f32x4*)dst + lane + 64 * j); } }
    float ss = 0.f;
#pragma unroll
    for (int j = 0; j < 8; ++j) ss += (v[j].x * v[j].x + v[j].y * v[j].y) + (v[j].z * v[j].z + v[j].w * v[j].w);
    if (na.fin_out) { float* p = na.fin_out + ho;
#pragma unroll
        for (int j = 0; j < 8; ++j) gt[j] = *(const f32x4*)(na.g + 4 * lane + 256 * j);
        __builtin_amdgcn_sched_barrier(0);
        const float rstd = 1.0f / sqrtf(wave_sum(ss) * (1.0f / D) + EPS);
#pragma unroll
        for (int j = 0; j < 8; ++j) ((f32x4*)p)[lane + 64 * j] = v[j] * rstd * gt[j];
        return; }
    const float* sh = na.shift + (size_t)mi * MODW; const float* scl = sh + D;
    f32x4 sv[8], hv[8];
#pragma unroll
    for (int j = 0; j < 8; ++j) { const int c = 4 * lane + 256 * j; gt[j] = *(const f32x4*)(na.g + c); sv[j] = *(const f32x4*)(scl + c); hv[j] = *(const f32x4*)(sh + c); }
    __builtin_amdgcn_sched_barrier(0);
    const float rstd = 1.0f / sqrtf(wave_sum(ss) * (1.0f / D) + EPS);
#pragma unroll
    for (int j = 0; j < 8; ++j) { const int c = 4 * lane + 256 * j; const f32x4 y = (v[j] * rstd * gt[j]) * (sv[j] + 1.0f) + hv[j];
        v2u w; w.x = cvt_pk_bf16(y.x, y.y); w.y = cvt_pk_bf16(y.z, y.w); *(v2u*)(na.XN + (size_t)r * D + c) = w; }
}
__device__ __forceinline__ void norm_two_rows(const NormArgs& na, int r0, int r1, int lane) {
    const int b = r0 / TOK, t0 = r0 - b * TOK, t1 = r1 - b * TOK; const bool isctx = t0 < CTXL; const int mi = isctx ? 8 : b;
    const size_t ho0 = isctx ? ((size_t)b * CTXL + t0) * D : ((size_t)b * SEQ + (t0 - CTXL)) * D, ho1 = isctx ? ((size_t)b * CTXL + t1) * D : ((size_t)b * SEQ + (t1 - CTXL)) * D;
    const GAS float* sb = (const GAS float*)(isctx ? na.ctx_src : na.lat_src);
    f32x4 v0[8], v1[8], gt[8]; v2u y0[8], y1[8];
#pragma unroll
    for (int j = 0; j < 8; ++j) { v0[j] = __builtin_nontemporal_load((const GAS f32x4*)(sb + ho0) + lane + 64 * j); v1[j] = __builtin_nontemporal_load((const GAS f32x4*)(sb + ho1) + lane + 64 * j); }
    if (na.Y) { const float* gp = na.gate + (size_t)mi * MODW;
#pragma unroll
        for (int j = 0; j < 8; ++j) { const int c = 4 * lane + 256 * j; y0[j] = __builtin_nontemporal_load((const v2u*)(na.Y + (size_t)r0 * D + c)); y1[j] = __builtin_nontemporal_load((const v2u*)(na.Y + (size_t)r1 * D + c)); gt[j] = *(const f32x4*)(gp + c); } }
    __builtin_amdgcn_sched_barrier(0);
    if (na.Y) {
#pragma unroll
        for (int j = 0; j < 8; ++j) { v0[j] += (f32x4){bflo(y0[j].x), bfhi(y0[j].x), bflo(y0[j].y), bfhi(y0[j].y)} * gt[j] * na.coef; v1[j] += (f32x4){bflo(y1[j].x), bfhi(y1[j].x), bflo(y1[j].y), bfhi(y1[j].y)} * gt[j] * na.coef; }
        GAS float* db = (GAS float*)(isctx ? na.ctx_dst : na.lat_dst);
#pragma unroll
        for (int j = 0; j < 8; ++j) { __builtin_nontemporal_store(v0[j], (GAS f32x4*)(db + ho0) + lane + 64 * j); __builtin_nontemporal_store(v1[j], (GAS f32x4*)(db + ho1) + lane + 64 * j); } }
    float ss0 = 0.f, ss1 = 0.f;
#pragma unroll
    for (int j = 0; j < 8; ++j) { ss0 += (v0[j].x * v0[j].x + v0[j].y * v0[j].y) + (v0[j].z * v0[j].z + v0[j].w * v0[j].w); ss1 += (v1[j].x * v1[j].x + v1[j].y * v1[j].y) + (v1[j].z * v1[j].z + v1[j].w * v1[j].w); }
    const float* sh = na.shift + (size_t)mi * MODW; const float* scl = sh + D;
    const float rstd0 = 1.0f / sqrtf(wave_sum(ss0) * (1.0f / D) + EPS), rstd1 = 1.0f / sqrtf(wave_sum(ss1) * (1.0f / D) + EPS);
#pragma unroll
    for (int jh = 0; jh < 8; jh += 4) { f32x4 gg[4], sv[4], hv[4];
#pragma unroll
        for (int j = 0; j < 4; ++j) { const int c = 4 * lane + 256 * (jh + j); gg[j] = *(const f32x4*)(na.g + c); sv[j] = *(const f32x4*)(scl + c); hv[j] = *(const f32x4*)(sh + c); }
        __builtin_amdgcn_sched_barrier(0);
#pragma unroll
        for (int j = 0; j < 4; ++j) { const int c = 4 * lane + 256 * (jh + j); const f32x4 ya = (v0[jh + j] * rstd0 * gg[j]) * (sv[j] + 1.0f) + hv[j], yb = (v1[jh + j] * rstd1 * gg[j]) * (sv[j] + 1.0f) + hv[j];
            v2u w; w.x = cvt_pk_bf16(ya.x, ya.y); w.y = cvt_pk_bf16(ya.z, ya.w); *(v2u*)(na.XN + (size_t)r0 * D + c) = w;
            v2u x; x.x = cvt_pk_bf16(yb.x, yb.y); x.y = cvt_pk_bf16(yb.z, yb.w); *(v2u*)(na.XN + (size_t)r1 * D + c) = x; }
        __builtin_amdgcn_sched_barrier(0); }
}
__device__ __forceinline__ void norm_rows(const NormArgs& na, int base, int idx0, int step, int lim, int lane) {
    for (int idx = idx0; idx < lim; ) { const int i1 = idx + step;
        if (i1 < lim && !na.fin_out && ((idx < CTXL) == (i1 < CTXL))) { norm_two_rows(na, base + idx, base + i1, lane); idx = i1 + step; }
        else { norm_one_row(na, base + idx, lane); idx = i1; } }
}
constexpr int PO_FULL = 4, PO_TAILSLOTS = 8, PO_READYP = 16;
constexpr int WO_FULL = 3, WO_TAILSLOTS = 20, WO_READYP = 12;
__device__ __forceinline__ void norm_all(const NormArgs& na) { PH_IDS; const int gx = (int)blockIdx.x & 7, wl = ((int)blockIdx.x >> 3) * 8 + wave; norm_rows(na, TOK * gx, wl, 256, TOK, lane); }
__device__ __forceinline__ void norm_ready(const NormArgs& na, int tailslots = PO_TAILSLOTS, int readyp = PO_READYP) {
    PH_IDS;
    const int gx = (int)blockIdx.x & 7, wi = (((int)blockIdx.x >> 3) - tailslots) * 8 + wave, nw = (32 - tailslots) * 8;
    norm_rows(na, TOK * gx, wi, nw, readyp * 256, lane);
}
__device__ __forceinline__ void norm_tail(const NormArgs& na, int readyp = PO_READYP) {
    PH_IDS;
    const int gx = (int)blockIdx.x & 7, wl = ((int)blockIdx.x >> 3) * 8 + wave;
    norm_rows(na, TOK * gx, readyp * 256 + wl, 256, TOK, lane);
}
__device__ __forceinline__ void norm_span(const NormArgs& na, bool tailwg, int tailslots, int readyp) {
    PH_IDS;
    const int gx = (int)blockIdx.x & 7, slot = (int)blockIdx.x >> 3;
    const int idx0 = tailwg ? readyp * 256 + slot * 8 + wave : (slot - tailslots) * 8 + wave, step = tailwg ? tailslots * 8 : (32 - tailslots) * 8, lim = tailwg ? TOK : readyp * 256;
    norm_rows(na, TOK * gx, idx0, step, lim, lane);
}
struct PanelOrder {
    int c, j0, stride, n;
    __device__ __forceinline__ bool next(int i, Unit& u) const { if (i >= n) return false; const int j = j0 + stride * i + (c >> 3); if (j >= 136) return false; u.pm = 17 * (c & 7) + (j >> 3); u.pn = j & 7; return true; }
    __device__ __forceinline__ void a_ready(const Unit&) const {}
    __device__ __forceinline__ void done(const Unit&) const {}
};
__device__ __forceinline__ void phase_fin(bf16* PA, bf16* PB, bf16* PC, const bf16* SO, bf16* Y3) {
    PH_IDS;
    const int gx = (int)blockIdx.x & 7, wl = ((int)blockIdx.x >> 3) * 8 + wave;
    for (int r = TOK * gx + wl; r < TOK * (gx + 1); r += 256) {
        const int c0 = 16 * lane; const size_t so = (size_t)r * 1024 + c0;
        v4u w[3][6];
        const bf16* gsrc[3] = {PA + (size_t)r * PA_LD + 3072 + c0, PB + (size_t)r * PB_LD + 4096 + c0, PC + (size_t)r * PC_LD + 1024 + c0};
#pragma unroll
        for (int br = 0; br < 3; ++br) { const bf16* f = SO + (size_t)(2 * br) * SO_STRIDE + so;
            w[br][0] = *(const v4u*)f; w[br][1] = *(const v4u*)(f + 8); w[br][2] = *(const v4u*)(f + SO_STRIDE); w[br][3] = *(const v4u*)(f + SO_STRIDE + 8);
            w[br][4] = *(const v4u*)gsrc[br]; w[br][5] = *(const v4u*)(gsrc[br] + 8); }
        __builtin_amdgcn_sched_barrier(0);
#pragma unroll
        for (int br = 0; br < 3; ++br) { float s[16], t[16], g[16];
            unpack8(w[br][0], *(float(*)[8])&s[0]); unpack8(w[br][1], *(float(*)[8])&s[8]); unpack8(w[br][2], *(float(*)[8])&t[0]); unpack8(w[br][3], *(float(*)[8])&t[8]);
            unpack8(w[br][4], *(float(*)[8])&g[0]); unpack8(w[br][5], *(float(*)[8])&g[8]);
            float ss = 0.f;
#pragma unroll
            for (int q = 0; q < 16; ++q) { s[q] += t[q]; ss += s[q] * s[q]; }
            float rs = 1.0f;
            if (br == 0) rs = 1.0f / sqrtf(group16_sum(ss) * (1.0f / 256.0f) + EPS);
            if (br == 1) rs = 1.0f / sqrtf(group8_sum(ss) * (1.0f / 128.0f) + EPS);
#pragma unroll
            for (int q = 0; q < 16; ++q) s[q] = s[q] * rs * g[q];
            bf16* y3 = Y3 + (size_t)r * 3072 + 1024 * br + c0; *(v4u*)y3 = pack8(*(float(*)[8])&s[0]); *(v4u*)(y3 + 8) = pack8(*(float(*)[8])&s[8]); }
    }
}

__device__ __forceinline__ int chunk_lo(int rowbase, int dir, int c) { return dir == 0 ? rowbase + 64 * c : (c < 4 ? rowbase + (CTXL - 64) - 64 * c : rowbase + (2 * CTXL + SEQ - 64) - 64 * c); }
__device__ __forceinline__ int chunk_po(int dir, int p) { return dir ? 63 - p : p; }
__device__ __forceinline__ int scan_row(int rowbase, int dir, int s) { return dir == 0 ? rowbase + s : (s < CTXL ? rowbase + (CTXL - 1) - s : rowbase + (2 * CTXL + SEQ - 1) - s); }

typedef short s16x4 __attribute__((ext_vector_type(4)));
typedef pg8::bf16x8 bfx8;
#define MFMA16(a, b, c) __builtin_amdgcn_mfma_f32_16x16x32_bf16((a), (b), (c), 0, 0, 0)
constexpr int ML_KS = 0, KS_LD = 264, ML_CT = 33792, CT_LD = 264, ML_VT = 76032, VT_LD = 72, ML_SS = 87552, SS_LD = 72, ML_OS = 96768;
__device__ __forceinline__ bfx8 ldfrag(const LAS unsigned char* p) { return *(const LAS bfx8*)p; }
__device__ __forceinline__ unsigned short bf16_1(float x) { return (unsigned short)(cvt_pk_bf16(x, 0.f) & 0xffffu); }
constexpr int ML_N1A = 107520;
constexpr int ML_GT = 104960;
__device__ __forceinline__ void scan_mlstm2(int item, int l, LAS unsigned char* lds) {
    PH_IDS;
    const int es = item & 3, dir = (item >> 2) & 1, hh = (item >> 3) & 3, b = item >> 5, rowbase = b * TOK;
    const bf16* PA = (const bf16*)(wsp(lds) + WS_PA); const bf16* GTB = (const bf16*)(wsp(lds) + WS_GTB); bf16* out = (bf16*)(wsp(lds) + WS_SO) + (size_t)dir * SO_STRIDE;
    const float bi = inp(lds, 10)[((l * 2 + dir) * 2 + 0) * 4 + hh], bfg = inp(lds, 10)[((l * 2 + dir) * 2 + 1) * 4 + hh];
    const int fr = lane & 15, fq = lane >> 4, gsel = wave >> 2, tt = gsel ? 3 - (wave & 3) : (wave & 3);
    LAS unsigned char* Ks = lds + ML_KS; LAS unsigned char* CT = lds + ML_CT; LAS unsigned char* VT = lds + ML_VT; LAS unsigned char* Ss = lds + ML_SS; LAS bf16* Os = (LAS bf16*)(lds + ML_OS);
    LAS float* GT = (LAS float*)(lds + ML_GT);
    constexpr int NC = TOK / 64;
    __syncthreads();
    for (int i = tid; i < (42240 + 11520) / 16; i += 512) *(LAS v4u*)(CT + 16 * i) = (v4u){0u, 0u, 0u, 0u};
    f32x4 Cacc[2][5];
#pragma unroll
    for (int i = 0; i < 2; ++i)
#pragma unroll
        for (int e = 0; e < 5; ++e) Cacc[i][e] = (f32x4){0.f, 0.f, 0.f, 0.f};
    float m_prev = 0.f;
    v4u qf[8], kp[4], vp; float gi_n = 0.f, gf_n = 0.f;
    const int ml_goff = chunk_po(dir, lane) * 256 + dir * 8 + hh;
#define ML_GLOAD(cn) do { const bf16* gp = GTB + (size_t)chunk_lo(rowbase, dir, (cn)) * 256 + ml_goff; gi_n = bf1(gp[0]); gf_n = bf1(gp[4]); } while (0)
#define ML_GATES(cn) do { LAS float* gt = GT + ((cn) & 1) * 320; \
        const float gi = gi_n + bi, gf = gf_n + bfg, lf = fminf(gf, 0.f) - 0.69314718f * __builtin_amdgcn_logf(1.0f + __builtin_amdgcn_exp2f(-1.44269504f * fabsf(gf))); \
        const float bc = wave_prefix_sum(lf), av = gi - bc, pm = wave_prefix_max(av); \
        const float mx = fmaxf(m_prev, pm), mx63 = __int_as_float(__builtin_amdgcn_readlane(__float_as_int(mx), 63)), b63 = __int_as_float(__builtin_amdgcn_readlane(__float_as_int(bc), 63)); \
        gt[lane] = __builtin_amdgcn_exp2f(1.44269504f * (m_prev - mx)); gt[64 + lane] = __builtin_amdgcn_exp2f(1.44269504f * (mx63 - mx)); gt[128 + lane] = __builtin_amdgcn_exp2f(-1.44269504f * (bc + mx)); \
        gt[192 + lane] = __builtin_amdgcn_exp2f(1.44269504f * (av - mx63)); gt[256 + lane] = __builtin_amdgcn_exp2f(1.44269504f * (m_prev - mx63)); m_prev = b63 + mx63; } while (0)
    const int ml_koff = (dir ? 15 - (tid >> 5) : (tid >> 5)) * PA_LD + 1024 + hh * 256 + 8 * (tid & 31), ml_voff = chunk_po(dir, lane) * PA_LD + 2048 + hh * 256 + es * 64 + 8 * wave;
    const int ml_qoff = chunk_po(dir, 16 * tt + fr) * PA_LD + hh * 256 + 8 * fq, ml_ooff = chunk_po(dir, tid >> 3) * 1024 + hh * 256 + es * 64 + 8 * (tid & 7);
#define ML_LOAD(cn) do { const bf16* cb = PA + (size_t)chunk_lo(rowbase, dir, (cn)) * PA_LD; \
        _Pragma("unroll") for (int i = 0; i < 4; ++i) kp[i] = *(const v4u*)(cb + (size_t)((dir ? 48 - 16 * i : 16 * i) * PA_LD) + ml_koff); \
        vp = *(const v4u*)(cb + ml_voff); } while (0)
#define ML_LOADQ(cn) do { const bf16* qp = PA + (size_t)chunk_lo(rowbase, dir, (cn)) * PA_LD + ml_qoff; _Pragma("unroll") for (int ks = 0; ks < 8; ++ks) qf[ks] = *(const v4u*)(qp + 32 * ks); } while (0)
#define ML_STAGE(cn) do { const float bs = GT[((cn) & 1) * 320 + 192 + olane]; \
        { LAS unsigned char* ksp = Ks + (((otid >> 5) * KS_LD) + 8 * (otid & 31)) * 2; _Pragma("unroll") for (int i = 0; i < 4; ++i) *(LAS v4u*)(ksp + i * (16 * KS_LD * 2)) = kp[i]; } \
        { LAS unsigned char* vtp = VT + ((8 * wave) * VT_LD + olane) * 2; float v[8]; unpack8(vp, v); \
          _Pragma("unroll") for (int i = 0; i < 8; i += 2) { const unsigned pk = cvt_pk_bf16(bs * v[i], bs * v[i + 1]); *(LAS unsigned short*)(vtp + i * (VT_LD * 2)) = (unsigned short)pk; *(LAS unsigned short*)(vtp + (i + 1) * (VT_LD * 2)) = (unsigned short)(pk >> 16); } \
          LAS unsigned char* vap = VT + ((64 + 2 * wave) * VT_LD + olane) * 2; const unsigned short b1 = bf16_1(bs); *(LAS unsigned short*)vap = b1; *(LAS unsigned short*)(vap + VT_LD * 2) = b1; } } while (0)
    int otid = tid, olane = lane;
    ML_LOAD(0); ML_LOADQ(0);
    if (wave == 7) { ML_GLOAD(0); ML_GATES(0); ML_GLOAD(1); }
    __syncthreads();
    ML_STAGE(0);
    for (int c = 0; c < NC; ++c) {
        __syncthreads();
        otid = tid; asm volatile("" : "+v"(otid)); olane = otid & 63;
        if (c > 0) *(v4u*)(out + (size_t)chunk_lo(rowbase, dir, c - 1) * 1024 + ml_ooff) = *(const LAS v4u*)(Os + (otid >> 3) * 64 + 8 * (otid & 7));
        if (c + 1 < NC) ML_LOAD(c + 1);
        if (wave == 7 && c + 1 < NC) { ML_GATES(c + 1); if (c + 2 < NC) ML_GLOAD(c + 2); }
        v2u spk[2];
#pragma unroll
        for (int si = 0; si < 2; ++si) { const int st = 2 * gsel + si; spk[si] = (v2u){0u, 0u};
            if (st <= tt) { f32x4 acc = (f32x4){0.f, 0.f, 0.f, 0.f}, acc2 = (f32x4){0.f, 0.f, 0.f, 0.f};
#pragma unroll
                for (int kh = 0; kh < 2; ++kh) { bfx8 kf[4];
#pragma unroll
                    for (int k4 = 0; k4 < 4; ++k4) kf[k4] = ldfrag(Ks + ((16 * st + fr) * KS_LD + 32 * (4 * kh + k4) + 8 * fq) * 2);
                    __builtin_amdgcn_sched_barrier(0);
#pragma unroll
                    for (int k4 = 0; k4 < 4; k4 += 2) { acc = MFMA16(kf[k4], __builtin_bit_cast(bfx8, qf[4 * kh + k4]), acc); acc2 = MFMA16(kf[k4 + 1], __builtin_bit_cast(bfx8, qf[4 * kh + k4 + 1]), acc2); }
                    __builtin_amdgcn_sched_barrier(0); }
                acc += acc2;
                if (st == tt) {
#pragma unroll
                    for (int j = 0; j < 4; ++j) if (4 * fq + j > fr) acc[j] = 0.f; }
                spk[si].x = cvt_pk_bf16(acc[0], acc[1]); spk[si].y = cvt_pk_bf16(acc[2], acc[3]); } }
        f32x4 N1[3], N2[3];
#pragma unroll
        for (int x = 0; x < 3; ++x) { N1[x] = (f32x4){0.f, 0.f, 0.f, 0.f}; N2[x] = (f32x4){0.f, 0.f, 0.f, 0.f}; }
#pragma unroll
        for (int ks = 0; ks < 8; ++ks) { bfx8 cf[3];
#pragma unroll
            for (int x = 0; x < 3; ++x) if (x < 2 || gsel == 0) { const int et = (x < 2) ? 2 * gsel + x : 4; cf[x] = ldfrag(CT + ((16 * et + fr) * CT_LD + 32 * ks + 8 * fq) * 2); }
            __builtin_amdgcn_sched_barrier(0);
#pragma unroll
            for (int x = 0; x < 3; ++x) if (x < 2 || gsel == 0) N1[x] = MFMA16(__builtin_bit_cast(bfx8, qf[ks]), cf[x], N1[x]);
            __builtin_amdgcn_sched_barrier(0); }
#pragma unroll
        for (int si = 0; si < 2; ++si) *(LAS v2u*)(Ss + ((16 * tt + fr) * SS_LD + 16 * (2 * gsel + si) + 4 * fq) * 2) = spk[si];
        if (gsel == 0 && fr == 0) *(LAS f32x4*)(lds + ML_N1A + (16 * tt + 4 * fq) * 4) = N1[2];
        __syncthreads();
        if (c + 1 < NC) ML_LOADQ(c + 1);
#pragma unroll
        for (int ks = 0; ks < 2; ++ks) if (ks == 0 || tt >= 2) { bfx8 vf[3];
            const bfx8 sf = ldfrag(Ss + ((16 * tt + fr) * SS_LD + 32 * ks + 8 * fq) * 2);
#pragma unroll
            for (int x = 0; x < 3; ++x) { const int et = (x < 2) ? 2 * gsel + x : 4; vf[x] = ldfrag(VT + ((16 * et + fr) * VT_LD + 32 * ks + 8 * fq) * 2); }
            __builtin_amdgcn_sched_barrier(0);
#pragma unroll
            for (int x = 0; x < 3; ++x) N2[x] = MFMA16(sf, vf[x], N2[x]);
            __builtin_amdgcn_sched_barrier(0); }
        { bfx8 Af[2][2]; const float decay_c = GT[(c & 1) * 320 + 256];
#pragma unroll
            for (int i = 0; i < 2; ++i)
#pragma unroll
                for (int ks = 0; ks < 2; ++ks) { LAS unsigned char* ap = Ks + ((32 * ks + 8 * fq + (fr >> 2)) * KS_LD + 16 * (2 * wave + i) + 4 * (fr & 3)) * 2;
                    const s16x4 r0 = __builtin_amdgcn_ds_read_tr16_b64_v4i16((LAS s16x4*)ap), r1 = __builtin_amdgcn_ds_read_tr16_b64_v4i16((LAS s16x4*)(ap + 4 * KS_LD * 2));
                    Af[i][ks] = (bfx8){r0[0], r0[1], r0[2], r0[3], r1[0], r1[1], r1[2], r1[3]}; }
#pragma unroll
            for (int e = 0; e < 5; ++e)
#pragma unroll
                for (int i = 0; i < 2; ++i) Cacc[i][e] *= decay_c;
#pragma unroll
            for (int ks = 0; ks < 2; ++ks)
#pragma unroll
                for (int eh = 0; eh < 5; eh += 3) { bfx8 vb[3];
#pragma unroll
                    for (int e = eh; e < 5 && e < eh + 3; ++e) vb[e - eh] = ldfrag(VT + ((16 * e + fr) * VT_LD + 32 * ks + 8 * fq) * 2);
                    __builtin_amdgcn_sched_barrier(0);
#pragma unroll
                    for (int e = eh; e < 5 && e < eh + 3; ++e)
#pragma unroll
                        for (int i = 0; i < 2; ++i) Cacc[i][e] = MFMA16(Af[i][ks], vb[e - eh], Cacc[i][e]);
                    __builtin_amdgcn_sched_barrier(0); }
#pragma unroll
            for (int e = 0; e < 5; ++e)
#pragma unroll
                for (int i = 0; i < 2; ++i) { v2u pk; pk.x = cvt_pk_bf16(Cacc[i][e][0], Cacc[i][e][1]); pk.y = cvt_pk_bf16(Cacc[i][e][2], Cacc[i][e][3]);
                    *(LAS v2u*)(CT + ((16 * e + fr) * CT_LD + 16 * (2 * wave + i) + 4 * fq) * 2) = pk; } }
        { const LAS float* gt = GT + (c & 1) * 320 + 16 * tt + 4 * fq; const f32x4 wi4 = *(const LAS f32x4*)gt, al4 = *(const LAS f32x4*)(gt + 64), em4 = *(const LAS f32x4*)(gt + 128);
            f32x4 n1a = N1[2]; if (gsel) n1a = *(const LAS f32x4*)(lds + ML_N1A + (16 * tt + 4 * fq) * 4);
            float rden[4];
#pragma unroll
            for (int j = 0; j < 4; ++j) rden[j] = wi4[j] * n1a[j] + al4[j] * N2[2][j];
#pragma unroll
            for (int j = 0; j < 4; ++j) rden[j] = __builtin_amdgcn_rcpf(fmaxf(fabsf(rden[j]), em4[j]));
#pragma unroll
            for (int j = 0; j < 4; ++j) { const int tl = 16 * tt + 4 * fq + j;
#pragma unroll
                for (int x = 0; x < 2; ++x) Os[tl * 64 + 16 * (2 * gsel + x) + fr] = bf16_1((wi4[j] * N1[x][j] + al4[j] * N2[x][j]) * rden[j]); } }
        __syncthreads();
        if (c + 1 < NC) ML_STAGE(c + 1);
    }
    *(v4u*)(out + (size_t)chunk_lo(rowbase, dir, NC - 1) * 1024 + ml_ooff) = *(const LAS v4u*)(Os + (tid >> 3) * 64 + 8 * (tid & 7));
#undef ML_GLOAD
#undef ML_GATES
#undef ML_LOAD
#undef ML_LOADQ
#undef ML_STAGE
}
constexpr int HG_Q = 0, HG_K = 17408, HG_ST = 34816, HG_VT = 52224, HG_SS = 61440, HG_OS = 70656, HG_PART = 81920, HG_ER = 80896, HG_EB = 81408, HQ_LD = 136;
__device__ __forceinline__ void scan_hgrn2(int item, int l, LAS unsigned char* lds) {
    PH_IDS;
    const int half = item & 1, dir = (item >> 1) & 1, hh = (item >> 2) & 7, b = item >> 5, rowbase = b * TOK;
    const bf16* PB = (const bf16*)(wsp(lds) + WS_PB); bf16* out = (bf16*)(wsp(lds) + WS_SO) + (size_t)(2 + dir) * SO_STRIDE;
    const int fr = lane & 15, fq = lane >> 4, tt = wave & 3, gsel = wave >> 2, pd = tid & 127, ptq = tid >> 7;
    const f32x2 lbv2 = *(const f32x2*)((const float*)(wsp(lds) + WS_LB) + (size_t)(l * 2 + dir) * 1024 + hh * 128 + 2 * lane);
    LAS unsigned char* HQ = lds + HG_Q; LAS unsigned char* HK = lds + HG_K; LAS unsigned char* ST = lds + HG_ST; LAS unsigned char* VT = lds + HG_VT; LAS unsigned char* Ss = lds + HG_SS;
    LAS bf16* Os = (LAS bf16*)(lds + HG_OS); LAS float* PART = (LAS float*)(lds + HG_PART); LAS float* ER = (LAS float*)(lds + HG_ER); LAS float* EB = (LAS float*)(lds + HG_EB);
    constexpr int NC = TOK / 64;
    f32x4 Sacc[4];
#pragma unroll
    for (int e = 0; e < 4; ++e) Sacc[e] = (f32x4){0.f, 0.f, 0.f, 0.f};
    v4u fp[2], qp[2], vp;
    const int hg_toff = chunk_po(dir, tid >> 3) * PB_LD + hh * 128 + 16 * (tid & 7), hg_voff = chunk_po(dir, tid >> 3) * PB_LD + 3072 + hh * 128 + half * 64 + 8 * (tid & 7);
    const int hg_ooff = chunk_po(dir, tid >> 3) * 1024 + hh * 128 + half * 64 + 8 * (tid & 7);
#define HG_LOAD(cn) do { const bf16* cb = PB + (size_t)chunk_lo(rowbase, dir, (cn)) * PB_LD; const bf16* rp = cb + hg_toff; \
        qp[0] = *(const v4u*)(rp); qp[1] = *(const v4u*)(rp + 8); fp[0] = *(const v4u*)(rp + (1 + dir) * 1024); fp[1] = *(const v4u*)(rp + (1 + dir) * 1024 + 8); \
        vp = *(const v4u*)(cb + hg_voff); } while (0)
    __syncthreads();
    HG_LOAD(0);
    for (int c = 0; c < NC; ++c) {
        { const int p = tid >> 3, ch = tid & 7;
            *(LAS v4u*)(HQ + (p * HQ_LD + 16 * ch) * 2) = qp[0]; *(LAS v4u*)(HQ + (p * HQ_LD + 16 * ch + 8) * 2) = qp[1];
            *(LAS v4u*)(HK + (p * HQ_LD + 16 * ch) * 2) = fp[0]; *(LAS v4u*)(HK + (p * HQ_LD + 16 * ch + 8) * 2) = fp[1];
            { LAS unsigned char* vtp = VT + ((8 * ch) * VT_LD + p) * 2; const unsigned w4[4] = {vp.x, vp.y, vp.z, vp.w};
#pragma unroll
                for (int i = 0; i < 4; ++i) { *(LAS unsigned short*)(vtp + (2 * i) * (VT_LD * 2)) = (unsigned short)w4[i]; *(LAS unsigned short*)(vtp + (2 * i + 1) * (VT_LD * 2)) = (unsigned short)(w4[i] >> 16); } } }
        if (c + 1 < NC) HG_LOAD(c + 1);
        __builtin_amdgcn_fence(__ATOMIC_RELEASE, "wavefront"); __builtin_amdgcn_wave_barrier();
        f32x2 ff2[8], qq2[8], cs2[8]; f32x2 run2 = (f32x2){0.f, 0.f};
        { const LAS unsigned char* kr = HK + ((8 * wave) * HQ_LD + 2 * lane) * 2; const LAS unsigned char* qr = HQ + ((8 * wave) * HQ_LD + 2 * lane) * 2; const f32x2 oml2 = 1.0f - lbv2;
            unsigned kw[8], qw[8];
#pragma unroll
            for (int i = 0; i < 8; ++i) { kw[i] = *(const LAS unsigned*)(kr + i * (HQ_LD * 2)); qw[i] = *(const LAS unsigned*)(qr + i * (HQ_LD * 2)); }
#pragma unroll
            for (int i = 0; i < 8; ++i) { const f32x2 x2 = (f32x2){bflo(kw[i]), bfhi(kw[i])}; qq2[i] = (f32x2){bflo(qw[i]), bfhi(qw[i])};
                const f32x2 t2 = x2 * -1.44269504f; const f32x2 d2 = (f32x2){__builtin_amdgcn_exp2f(t2.x), __builtin_amdgcn_exp2f(t2.y)} + 1.0f;
                const f32x2 f2 = (f32x2){__builtin_amdgcn_rcpf(d2.x), __builtin_amdgcn_rcpf(d2.y)} * oml2 + lbv2; ff2[i] = f2;
                run2 += (f32x2){fmaxf(__builtin_amdgcn_logf(f2.x), -126.0f), fmaxf(__builtin_amdgcn_logf(f2.y), -126.0f)}; cs2[i] = run2; } }
        *(LAS f32x2*)(PART + wave * 128 + 2 * lane) = run2;
        __syncthreads();
        { f32x2 pg[8];
#pragma unroll
            for (int g = 0; g < 8; ++g) pg[g] = *(const LAS f32x2*)(PART + g * 128 + 2 * lane);
            const f32x2 r = (pg[0] + pg[1]) + (pg[2] + pg[3]), b63 = r + ((pg[4] + pg[5]) + (pg[6] + pg[7]));
            f32x2 before = (f32x2){0.f, 0.f};
#pragma unroll
            for (int g = 0; g < 7; ++g) if (g < wave) before += pg[g];
            const f32x2 offr = before - r;
            LAS unsigned char* qwp = HQ + ((8 * wave) * HQ_LD + 2 * lane) * 2; LAS unsigned char* kwp = HK + ((8 * wave) * HQ_LD + 2 * lane) * 2;
#pragma unroll
            for (int i = 0; i < 8; ++i) { const f32x2 db = cs2[i] + offr; const f32x2 nd = db * -1.0f;
                const f32x2 eq = (f32x2){__builtin_amdgcn_exp2f(fmaxf(db.x, -100.0f)), __builtin_amdgcn_exp2f(fmaxf(db.y, -100.0f))}, ek = (f32x2){__builtin_amdgcn_exp2f(fminf(nd.x, 100.0f)), __builtin_amdgcn_exp2f(fminf(nd.y, 100.0f))};
                const f32x2 qv = qq2[i] * eq, kv = (1.0f - ff2[i]) * ek;
                *(LAS unsigned*)(qwp + i * (HQ_LD * 2)) = cvt_pk_bf16(qv.x, qv.y); *(LAS unsigned*)(kwp + i * (HQ_LD * 2)) = cvt_pk_bf16(kv.x, kv.y); }
            if (wave == 0) { *(LAS f32x2*)(ER + 2 * lane) = (f32x2){__builtin_amdgcn_exp2f(r.x), __builtin_amdgcn_exp2f(r.y)}; *(LAS f32x2*)(EB + 2 * lane) = (f32x2){__builtin_amdgcn_exp2f(b63.x - r.x), __builtin_amdgcn_exp2f(b63.y - r.y)}; } }
        __syncthreads();
        { const f32x4 er4 = *(const LAS f32x4*)(ER + 16 * wave + 4 * fq);
#pragma unroll
            for (int e = 0; e < 4; ++e) { Sacc[e] *= er4; v2u pk; pk.x = cvt_pk_bf16(Sacc[e][0], Sacc[e][1]); pk.y = cvt_pk_bf16(Sacc[e][2], Sacc[e][3]);
                *(LAS v2u*)(ST + ((16 * e + fr) * HQ_LD + 16 * wave + 4 * fq) * 2) = pk; } }
        { bfx8 qfr[4]; v2u spk[2];
#pragma unroll
            for (int ks = 0; ks < 4; ++ks) qfr[ks] = ldfrag(HQ + ((16 * tt + fr) * HQ_LD + 32 * ks + 8 * fq) * 2);
#pragma unroll
            for (int si = 0; si < 2; ++si) { const int st = 2 * gsel + si; spk[si] = (v2u){0u, 0u};
                if (st <= tt) { bfx8 kfr[4];
#pragma unroll
                    for (int ks = 0; ks < 4; ++ks) kfr[ks] = ldfrag(HK + ((16 * st + fr) * HQ_LD + 32 * ks + 8 * fq) * 2);
                    __builtin_amdgcn_sched_barrier(0);
                    f32x4 acc = (f32x4){0.f, 0.f, 0.f, 0.f}, acc2 = (f32x4){0.f, 0.f, 0.f, 0.f};
#pragma unroll
                    for (int ks = 0; ks < 4; ks += 2) { acc = MFMA16(kfr[ks], qfr[ks], acc); acc2 = MFMA16(kfr[ks + 1], qfr[ks + 1], acc2); }
                    acc += acc2;
                    if (st == tt) {
#pragma unroll
                        for (int j = 0; j < 4; ++j) if (4 * fq + j > fr) acc[j] = 0.f; }
                    spk[si].x = cvt_pk_bf16(acc[0], acc[1]); spk[si].y = cvt_pk_bf16(acc[2], acc[3]);
                    __builtin_amdgcn_sched_barrier(0); } }
#pragma unroll
            for (int si = 0; si < 2; ++si) *(LAS v2u*)(Ss + ((16 * tt + fr) * SS_LD + 16 * (2 * gsel + si) + 4 * fq) * 2) = spk[si]; }
        __syncthreads();
        { f32x4 O[2]; O[0] = (f32x4){0.f, 0.f, 0.f, 0.f}; O[1] = (f32x4){0.f, 0.f, 0.f, 0.f};
#pragma unroll
            for (int kh = 0; kh < 2; ++kh) { bfx8 af[2], sf[2][2];
#pragma unroll
                for (int k2 = 0; k2 < 2; ++k2) { af[k2] = ldfrag(HQ + ((16 * tt + fr) * HQ_LD + 32 * (2 * kh + k2) + 8 * fq) * 2);
#pragma unroll
                    for (int x = 0; x < 2; ++x) sf[k2][x] = ldfrag(ST + ((16 * (2 * gsel + x) + fr) * HQ_LD + 32 * (2 * kh + k2) + 8 * fq) * 2); }
                __builtin_amdgcn_sched_barrier(0);
#pragma unroll
                for (int k2 = 0; k2 < 2; ++k2)
#pragma unroll
                    for (int x = 0; x < 2; ++x) O[x] = MFMA16(af[k2], sf[k2][x], O[x]);
                __builtin_amdgcn_sched_barrier(0); }
#pragma unroll
            for (int ks = 0; ks < 2; ++ks) if (ks == 0 || tt >= 2) { bfx8 vf[2]; const bfx8 af = ldfrag(Ss + ((16 * tt + fr) * SS_LD + 32 * ks + 8 * fq) * 2);
#pragma unroll
                for (int x = 0; x < 2; ++x) vf[x] = ldfrag(VT + ((16 * (2 * gsel + x) + fr) * VT_LD + 32 * ks + 8 * fq) * 2);
                __builtin_amdgcn_sched_barrier(0);
#pragma unroll
                for (int x = 0; x < 2; ++x) O[x] = MFMA16(af, vf[x], O[x]);
                __builtin_amdgcn_sched_barrier(0); }
            bfx8 Af[2];
#pragma unroll
            for (int ks = 0; ks < 2; ++ks) { LAS unsigned char* ap = HK + ((32 * ks + 8 * fq + (fr >> 2)) * HQ_LD + 16 * wave + 4 * (fr & 3)) * 2;
                const s16x4 r0 = __builtin_amdgcn_ds_read_tr16_b64_v4i16((LAS s16x4*)ap), r1 = __builtin_amdgcn_ds_read_tr16_b64_v4i16((LAS s16x4*)(ap + 4 * HQ_LD * 2));
                Af[ks] = (bfx8){r0[0], r0[1], r0[2], r0[3], r1[0], r1[1], r1[2], r1[3]}; }
            const f32x4 eb4 = *(const LAS f32x4*)(EB + 16 * wave + 4 * fq);
#pragma unroll
            for (int ks = 0; ks < 2; ++ks) { bfx8 vb[4];
#pragma unroll
                for (int e = 0; e < 4; ++e) vb[e] = ldfrag(VT + ((16 * e + fr) * VT_LD + 32 * ks + 8 * fq) * 2);
                __builtin_amdgcn_sched_barrier(0);
#pragma unroll
                for (int e = 0; e < 4; ++e) Sacc[e] = MFMA16(Af[ks], vb[e], Sacc[e]);
                __builtin_amdgcn_sched_barrier(0); }
#pragma unroll
            for (int e = 0; e < 4; ++e) Sacc[e] *= eb4;
#pragma unroll
            for (int j = 0; j < 4; ++j)
#pragma unroll
                for (int x = 0; x < 2; ++x) Os[(16 * tt + 4 * fq + j) * 64 + 16 * (2 * gsel + x) + fr] = bf16_1(O[x][j]); }
        __syncthreads();
        *(v4u*)(out + (size_t)chunk_lo(rowbase, dir, c) * 1024 + hg_ooff) = *(const LAS v4u*)(Os + (tid >> 3) * 64 + 8 * (tid & 7));
    }
#undef HG_LOAD
}
constexpr int RW_LD = 72;
constexpr int R3_X = 0, R3_UB = 17408, R3_A = 35840, R3_BX = 68608, R3_H = 84992, R3_W = 101376, R3_C = 119808;
__device__ __forceinline__ void scan_rglru3(int item, int l, LAS unsigned char* lds) {
    PH_IDS;
    const int dir = item & 1, blk = (item >> 1) & 15, b = item >> 5, rowbase = b * TOK;
    const bf16* PC = (const bf16*)(wsp(lds) + WS_PC); bf16* out = (bf16*)(wsp(lds) + WS_SO) + (size_t)(4 + dir) * SO_STRIDE;
    LAS unsigned char* Wg = lds + R3_W; LAS float* cst = (LAS float*)(lds + R3_C);
    const int fr = lane & 15, fq = lane >> 4, tt = wave & 3, st_t = tid >> 3, st_c = tid & 7;
    constexpr int NC = TOK / 64;
    __syncthreads();
    { const float* w = inp(lds, 14) + (size_t)((l * 2 + dir) * 2) * 16 * 4096;
#pragma unroll 4
        for (int i = 0; i < 16; ++i) { const int idx = tid + 512 * i, c = idx & 63, k = (idx >> 6) & 63, g = idx >> 12;
            *(LAS unsigned short*)(Wg + ((64 * g + c) * RW_LD + k) * 2) = bf16_1(w[((size_t)g * 16 + blk) * 4096 + k * 64 + c]); }
        if (tid < 64) { const int ch = blk * 64 + tid; cst[tid] = inp(lds, 15)[((l * 2 + dir) * 2 + 0) * 1024 + ch]; cst[64 + tid] = inp(lds, 15)[((l * 2 + dir) * 2 + 1) * 1024 + ch];
            cst[128 + tid] = -8.0f * log1pf(expf(-inp(lds, 16)[(l * 2 + dir) * 1024 + ch])); cst[448 + tid] = inp(lds, 13)[l * 1024 + ch];
#pragma unroll
            for (int tp = 0; tp < 4; ++tp) cst[192 + 64 * tp + tid] = inp(lds, 12)[(l * 4 + tp) * 1024 + ch]; } }
    v4u xp0 = (v4u){0u, 0u, 0u, 0u}, xh0 = xp0, xp1 = xp0, xh1 = xp0, xp2 = xp0, xh2 = xp0;
#define R3_TILE(cn, isctx_, Lseg_, a0_) const bool isctx_ = (cn) < 4; const int Lseg_ = isctx_ ? CTXL : SEQ, a0_ = dir ? (Lseg_ - 64) - 64 * (isctx_ ? (cn) : (cn) - 4) : 64 * (isctx_ ? (cn) : (cn) - 4)
#define R3_ROW(ic, pos) ((ic) ? rowbase + (pos) : rowbase + CTXL + ((pos) & 63) * 64 + ((pos) >> 6))
#define R3_LOAD(cn, xp, xh) do { R3_TILE(cn, ic, Ls, a0); { const int pos = a0 - 2 + st_t; xp = (v4u){0u, 0u, 0u, 0u}; if (pos >= 0 && pos < Ls) xp = *(const v4u*)(PC + (size_t)R3_ROW(ic, pos) * PC_LD + blk * 64 + 8 * st_c); } \
        if (tid < 24) { const int pos = a0 + 62 + st_t; xh = (v4u){0u, 0u, 0u, 0u}; if (pos >= 0 && pos < Ls) xh = *(const v4u*)(PC + (size_t)R3_ROW(ic, pos) * PC_LD + blk * 64 + 8 * st_c); } } while (0)
    R3_LOAD(0, xp0, xh0); R3_LOAD(1, xp1, xh1); R3_LOAD(2, xp2, xh2);
    float hstate = 0.f;
    __syncthreads();
    f32x4 cw[4][2], cbias[2];
#pragma unroll
    for (int tp = 0; tp < 4; ++tp) { cw[tp][0] = *(const LAS f32x4*)(cst + 192 + 64 * tp + 8 * st_c); cw[tp][1] = *(const LAS f32x4*)(cst + 192 + 64 * tp + 8 * st_c + 4); }
    cbias[0] = *(const LAS f32x4*)(cst + 448 + 8 * st_c); cbias[1] = *(const LAS f32x4*)(cst + 448 + 8 * st_c + 4);
    static_assert((NC + 4) % 3 == 0, "the tile loop is unrolled by three (one prefetch register set per residue)");
    for (int it0 = 0; it0 < NC + 4; it0 += 3) {
#pragma unroll
      for (int rr = 0; rr < 3; ++rr) { const int it = it0 + rr;
        __syncthreads();
        if (it < NC) { LAS unsigned char* xs = lds + R3_X + (it & 1) * 8704; const v4u xp = rr == 0 ? xp0 : rr == 1 ? xp1 : xp2, xh = rr == 0 ? xh0 : rr == 1 ? xh1 : xh2;
            *(LAS v4u*)(xs + (st_t * 64 + 8 * st_c) * 2) = xp; if (tid < 24) *(LAS v4u*)(xs + ((64 + st_t) * 64 + 8 * st_c) * 2) = xh; }
        if (it + 3 < NC) { if (rr == 0) R3_LOAD(it + 3, xp0, xh0); else if (rr == 1) R3_LOAD(it + 3, xp1, xh1); else R3_LOAD(it + 3, xp2, xh2); }
        if (it >= 1 && it - 1 < NC) { const int cn = it - 1; const LAS unsigned char* xs = lds + R3_X + (cn & 1) * 8704; LAS unsigned char* ub = lds + R3_UB + (cn & 1) * 9216; float u[8];
#pragma unroll
            for (int q = 0; q < 8; ++q) u[q] = cbias[q >> 2][q & 3];
            v4u xr[4];
#pragma unroll
            for (int tp = 0; tp < 4; ++tp) xr[tp] = *(const LAS v4u*)(xs + ((st_t + tp) * 64 + 8 * st_c) * 2);
#pragma unroll
            for (int tp = 0; tp < 4; ++tp) { float x[8]; unpack8(xr[tp], x);
                const f32x4 c0 = cw[tp][0], c1 = cw[tp][1];
                u[0] += c0.x * x[0]; u[1] += c0.y * x[1]; u[2] += c0.z * x[2]; u[3] += c0.w * x[3]; u[4] += c1.x * x[4]; u[5] += c1.y * x[5]; u[6] += c1.z * x[6]; u[7] += c1.w * x[7]; }
            *(LAS v4u*)(ub + (st_t * RW_LD + 8 * st_c) * 2) = pack8(u); }
        if (it >= 2 && it - 2 < NC) { const int cn = it - 2; const LAS unsigned char* ub = lds + R3_UB + (cn & 1) * 9216; LAS float* as = (LAS float*)(lds + R3_A + (cn & 1) * 16384); LAS unsigned short* bxs = (LAS unsigned short*)(lds + R3_BX + (cn & 1) * 8192);
            const int q0 = wave == 0 ? 0 : wave == 4 ? 1 : 2 * (wave >> 2), q1 = wave == 0 ? 1 : wave == 4 ? 4 : 2 * (wave >> 2) + 2;
            bfx8 af[2];
#pragma unroll
            for (int ks = 0; ks < 2; ++ks) af[ks] = ldfrag(ub + ((16 * tt + fr) * RW_LD + 32 * ks + 8 * fq) * 2);
#pragma unroll 1
            for (int q = q0; q < q1; ++q) { const int ch = 16 * q + fr;
                bfx8 wf[2][2]; float uu[4];
#pragma unroll
                for (int ks = 0; ks < 2; ++ks)
#pragma unroll
                    for (int g = 0; g < 2; ++g) wf[ks][g] = ldfrag(Wg + ((64 * g + ch) * RW_LD + 32 * ks + 8 * fq) * 2);
                const float cb0 = cst[ch], cb1 = cst[64 + ch], cb2 = cst[128 + ch];
#pragma unroll
                for (int j = 0; j < 4; ++j) uu[j] = bf1(*(const LAS bf16*)(ub + ((16 * tt + 4 * fq + j) * RW_LD + ch) * 2));
                __builtin_amdgcn_sched_barrier(0);
                f32x4 G0 = (f32x4){0.f, 0.f, 0.f, 0.f}, G1 = (f32x4){0.f, 0.f, 0.f, 0.f};
#pragma unroll
                for (int ks = 0; ks < 2; ++ks) { G0 = MFMA16(af[ks], wf[ks][0], G0); G1 = MFMA16(af[ks], wf[ks][1], G1); }
                __builtin_amdgcn_sched_barrier(0);
#pragma unroll
                for (int j = 0; j < 4; ++j) { const int t = 16 * tt + 4 * fq + j, o = t * 64 + ch; const float r = sigmoid_f(G0[j] + cb0), ig = sigmoid_f(G1[j] + cb1), loga2 = 1.44269504f * cb2 * r;
                    const float av = __builtin_amdgcn_exp2f(loga2); as[o] = av; bxs[o] = bf16_1(__builtin_amdgcn_sqrtf(fmaxf(1.0f - av * av, 0.f)) * (ig * uu[j])); } } }
        if (wave == 0 && it >= 3 && it - 3 < NC) { const int cn = it - 3; const LAS float* as = (const LAS float*)(lds + R3_A + (cn & 1) * 16384); const LAS unsigned short* bxs = (const LAS unsigned short*)(lds + R3_BX + (cn & 1) * 8192);
            LAS unsigned short* hs = (LAS unsigned short*)(lds + R3_H + (cn & 1) * 8192); float h = hstate;
            const LAS float* asl = as + lane; const LAS unsigned short* bxl = bxs + lane; LAS unsigned short* hsl = hs + lane;
#define R3_BASES(t0_) unsigned ab_ = (unsigned)(uintptr_t)(asl + (t0_) * 64), bb_ = (unsigned)(uintptr_t)(bxl + (t0_) * 64), hb_ = (unsigned)(uintptr_t)(hsl + (t0_) * 64); asm volatile("" : "+v"(ab_), "+v"(bb_), "+v"(hb_)); \
            const LAS float* ap = (const LAS float*)(uintptr_t)ab_; const LAS unsigned short* bp = (const LAS unsigned short*)(uintptr_t)bb_; LAS unsigned short* hp = (LAS unsigned short*)(uintptr_t)hb_
            if (!dir) {
#pragma unroll 1
                for (int tb = 0; tb < 64; tb += 16) { float av[16], bv[16]; R3_BASES(tb);
#pragma unroll
                    for (int k = 0; k < 16; ++k) { av[k] = ap[k * 64]; bv[k] = bf1(bp[k * 64]); }
#pragma unroll
                    for (int k = 0; k < 16; ++k) { h = av[k] * h + bv[k]; av[k] = h; }
#pragma unroll
                    for (int k = 0; k < 16; ++k) hp[k * 64] = bf16_1(av[k]); }
            } else {
#pragma unroll 1
                for (int tb = 0; tb < 64; tb += 16) { float av[16], bv[16]; R3_BASES(48 - tb);
#pragma unroll
                    for (int k = 0; k < 16; ++k) { av[k] = ap[(15 - k) * 64]; bv[k] = bf1(bp[(15 - k) * 64]); }
#pragma unroll
                    for (int k = 0; k < 16; ++k) { h = av[k] * h + bv[k]; av[k] = h; }
#pragma unroll
                    for (int k = 0; k < 16; ++k) hp[(15 - k) * 64] = bf16_1(av[k]); }
            }
            hstate = h; }
        if (it >= 4) { const int cn = it - 4; R3_TILE(cn, ic, Ls, a0); (void)Ls; const int pos = a0 + st_t;
            *(v4u*)(out + (size_t)R3_ROW(ic, pos) * 1024 + blk * 64 + 8 * st_c) = *(const LAS v4u*)(lds + R3_H + (cn & 1) * 8192 + (st_t * 64 + 8 * st_c) * 2); }
      }
    }
#undef R3_BASES
#undef R3_TILE
#undef R3_ROW
#undef R3_LOAD
}

__global__ void __launch_bounds__(512, 2) fwd_kernel(Args a) {
    extern __shared__ __attribute__((aligned(16))) unsigned char lds_raw[];
    LAS unsigned char* lds = (LAS unsigned char*)lds_raw;
    const int tid = threadIdx.x; const int G = gridDim.x;
    volatile LAS unsigned* MISC = (volatile LAS unsigned*)(lds + LDSCTL_OFF);
    if (tid < 64) MISC[tid] = 0u;
    if (tid < 44) ((volatile LAS unsigned*)(lds + TBL_OFF))[tid] = ((const unsigned*)__builtin_amdgcn_kernarg_segment_ptr())[tid];
    __syncthreads();
    (void)xcd_barrier_post((unsigned*)(a.ws + WS_CTL) + CW_BAR, MISC + 8);
#define EPI_ALIGN true
#define BARRIER() do { XcdBarrier b_; b_.bar = (unsigned*)(wsp(lds) + WS_CTL) + CW_BAR; b_.x = xb_xcc_id(); b_.st = (volatile LAS unsigned*)(lds + LDSCTL_OFF) + 8; xcd_barrier(b_); } while (0)
#define GBARRIER() grp_barrier((unsigned*)(wsp(lds) + WS_CTL) + CW_GBAR, (unsigned*)(wsp(lds) + WS_CTL) + CW_BAR, (volatile LAS unsigned*)(lds + LDSCTL_OFF) + 8)
#define WS(off) (wsp(lds) + (off))
    phase_mods(lds, 0, 1, (int)blockIdx.x, G, true); phase_convert(0, lds);
    grp_barrier_post((unsigned*)(wsp(lds) + WS_CTL) + CW_GBAR);
    BARRIER();
    grp_barrier_census((unsigned*)(wsp(lds) + WS_CTL) + CW_GBAR, (volatile LAS unsigned*)(lds + LDSCTL_OFF) + 8);
    __syncthreads();
#define FAST() (__builtin_amdgcn_readfirstlane((int)((volatile LAS unsigned*)(lds + LDSCTL_OFF))[10]) == 32 && __builtin_amdgcn_readfirstlane((int)((volatile LAS unsigned*)(lds + LDSCTL_OFF))[11]) == 1)
#define SUBBAR(cw, gw, n) sub_barrier((unsigned*)(wsp(lds) + WS_CTL) + CW_GBAR, (unsigned*)(wsp(lds) + WS_CTL) + CW_BAR, cw((unsigned)blockIdx.x & 7u), gw((unsigned)blockIdx.x & 7u), n)
#pragma unroll 1
    for (int l = 0; l < NL; ++l) {
        const float* modsb = (const float*)WS(WS_MODS);
        const size_t wset = (size_t)(l & 1) * WSET_STRIDE;
        { NormArgs na{l == 0 ? inp(lds, 0) : outp(lds), l == 0 ? inp(lds, 2) : (const float*)WS(WS_HC), outp(lds), (float*)WS(WS_HC), l == 0 ? nullptr : (const bf16*)WS(WS_Y),
                      modsb + (size_t)(l - 1) * 9 * MODW + 8 * D, 0.5f, inp(lds, 6) + (size_t)(l * 3) * D, modsb + (size_t)l * 9 * MODW, (bf16*)WS(WS_XN), nullptr};
            if (l == 0) norm_all(na); else if (!FAST()) norm_tail(na); }
        if (l == 0 || !FAST()) GBARRIER();
#pragma unroll 1
        for (int half = 0; half < 2; ++half) {
            { pg8::Gemm g{(const bf16*)WS(WS_XN), (const bf16*)WS(wset + WS_W1T) + (size_t)half * 2 * DFF * D, M, 2 * DFF, D, D, D}; const int lat = (l == NL - 1 && half == 1);
                pg8::StaticOrder S; S.init(lat ? NB * SEQ : M, 2 * DFF, G, (int)blockIdx.x, lat);
                EpiSwiGLU E{(bf16*)WS(WS_SO)};
                pg8::gemm_phase<EpiSwiGLU, pg8::StaticOrder, EPI_ALIGN, true>(lds, g, S, E); }
            if (l + 1 < NL && blockIdx.x >= 96) convert_in_tail(l + 1, half, lds);
            GBARRIER();
            { pg8::Gemm g{(const bf16*)WS(WS_SO), (const bf16*)WS(wset + WS_W2T) + (size_t)half * D * DFF, M, D, DFF, DFF, DFF}; EpiStoreBf16 E{(bf16*)WS(WS_Y)};
#pragma unroll 1
                for (int part = 0; part < 2; ++part) {
                    if (part) GBARRIER();
                    const bool tailwg = ((int)blockIdx.x >> 3) < PO_TAILSLOTS;
                    if (part == 0 || tailwg) { PanelOrder S{(int)blockIdx.x, part ? 32 * PO_FULL : 0, part ? PO_TAILSLOTS : 32, part ? 1 : PO_FULL}; pg8::gemm_phase<EpiStoreBf16, PanelOrder, EPI_ALIGN, true>(lds, g, S, E); }
                    if (part && (!tailwg || FAST())) {
                    if (tailwg) SUBBAR(GB_SUBA, GB_SUBAGEN, (unsigned)PO_TAILSLOTS);
                    const bool fin = (half == 1 && l == NL - 1); const int ln = half ? l + 1 : l;
                    NormArgs na{(l == 0 && half == 0) ? inp(lds, 0) : outp(lds), (l == 0 && half == 0) ? inp(lds, 2) : (const float*)WS(WS_HC), outp(lds), (float*)WS(WS_HC), (const bf16*)WS(WS_Y),
                                modsb + (size_t)l * 9 * MODW + (half ? 8 : 2) * D, 0.5f, fin ? inp(lds, 19) : inp(lds, 6) + (size_t)(ln * 3 + (half ? 0 : 1)) * D,
                                modsb + (size_t)(fin ? l : ln) * 9 * MODW + (half ? 0 : 3) * D, (bf16*)WS(WS_XN), fin ? outp(lds) : nullptr};
                    norm_span(na, tailwg, PO_TAILSLOTS, PO_READYP); } } }
            if (half) BARRIER(); else GBARRIER();
            if (half == 0) {
                { NormArgs na{l == 0 ? inp(lds, 0) : outp(lds), l == 0 ? inp(lds, 2) : (const float*)WS(WS_HC), outp(lds), (float*)WS(WS_HC), (const bf16*)WS(WS_Y),
                              modsb + (size_t)l * 9 * MODW + 2 * D, 0.5f, inp(lds, 6) + (size_t)(l * 3 + 1) * D, modsb + (size_t)l * 9 * MODW + 3 * D, (bf16*)WS(WS_XN), nullptr};
                    if (!FAST()) norm_tail(na); }
                if (!FAST()) GBARRIER();
                { pg8::Gemm g{(const bf16*)WS(WS_XN), (const bf16*)WS(wset + WS_WINT), M, INP, D, D, D}; pg8::StaticOrder S; S.init(M, INP, G, (int)blockIdx.x);
                    EpiInProj E{(bf16*)WS(WS_PA), (bf16*)WS(WS_PB), (bf16*)WS(WS_PC), (bf16*)WS(WS_PG), (bf16*)WS(WS_GTB)};
                    pg8::gemm_phase<EpiInProj, pg8::StaticOrder, EPI_ALIGN, true>(lds, g, S, E); }
                BARRIER();
                for (int i0 = blockIdx.x; i0 < 256; i0 += G) scan_mlstm2(((i0 & 7) << 5) | (i0 >> 3), l, lds);
                for (int i0 = blockIdx.x; i0 < 256; i0 += G) scan_hgrn2(((i0 & 7) << 5) | (i0 >> 3), l, lds);
                for (int i0 = blockIdx.x; i0 < 256; i0 += G) scan_rglru3(((i0 & 7) << 5) | (i0 >> 3), l, lds);
                GBARRIER();
                phase_fin((bf16*)WS(WS_PA), (bf16*)WS(WS_PB), (bf16*)WS(WS_PC), (const bf16*)WS(WS_SO), (bf16*)WS(WS_Y3));
                GBARRIER();
                { pg8::StaticOrder S; S.init(l == NL - 1 ? NB * SEQ : M, D, G, (int)blockIdx.x, l == NL - 1);
#pragma unroll 1
                    for (int br = 0; br < 3; ++br) {
                        pg8::Gemm g{(const bf16*)WS(WS_Y3) + br * 1024, (const bf16*)WS(wset + WS_WBRT) + br * 1024, M, D, 1024, 3072, 3072}; EpiBranch E{(const bf16*)WS(WS_PG), (bf16*)WS(WS_XN), br};
                        pg8::gemm_phase<EpiBranch, pg8::StaticOrder, EPI_ALIGN, true>(lds, g, S, E); } }
                if (l + 1 < NL && blockIdx.x >= 64) { __syncthreads(); phase_mods(lds, l + 1, l + 2, (int)blockIdx.x - 64, 192, false); }
                BARRIER();
                { pg8::Gemm g{(const bf16*)WS(WS_XN), (const bf16*)WS(wset + WS_WOT), M, D, D, D, D}; EpiStoreBf16 E{(bf16*)WS(WS_Y)};
#define NA_WOUT NormArgs na{outp(lds), (const float*)WS(WS_HC), outp(lds), (float*)WS(WS_HC), (const bf16*)WS(WS_Y), modsb + (size_t)l * 9 * MODW + 5 * D, 1.0f, \
                                inp(lds, 6) + (size_t)(l * 3 + 2) * D, modsb + (size_t)l * 9 * MODW + 6 * D, (bf16*)WS(WS_XN), nullptr}
#pragma unroll 1
                    for (int part = 0; part < 2; ++part) {
                        if (part) GBARRIER();
                        const bool tailwg = ((int)blockIdx.x >> 3) < WO_TAILSLOTS;
                        if (part == 0 || tailwg) { PanelOrder S{(int)blockIdx.x, part ? 32 * WO_FULL : 0, part ? WO_TAILSLOTS : 32, part ? 2 : WO_FULL}; pg8::gemm_phase<EpiStoreBf16, PanelOrder, EPI_ALIGN, true>(lds, g, S, E); }
                        if (part && (!tailwg || FAST())) {
                            if (tailwg) SUBBAR(GB_SUBB, GB_SUBBGEN, (unsigned)WO_TAILSLOTS);
                            NA_WOUT; norm_span(na, tailwg, WO_TAILSLOTS, WO_READYP); } }
                    GBARRIER();
                    if (!FAST()) { NA_WOUT; norm_tail(na, WO_READYP); } }
#undef NA_WOUT
                if (!FAST()) GBARRIER();
            }
        }
    }
    { const float* modsb = (const float*)WS(WS_MODS);
        NormArgs na{outp(lds), (const float*)WS(WS_HC), outp(lds), (float*)WS(WS_HC), (const bf16*)WS(WS_Y), modsb + (size_t)(NL - 1) * 9 * MODW + 8 * D, 0.5f, inp(lds, 19), modsb, (bf16*)WS(WS_XN), outp(lds)};
        if (!FAST()) norm_tail(na); }
#undef FAST
#undef SUBBAR
#undef BARRIER
#undef GBARRIER
#undef WS
#undef EPI_ALIGN
}

extern "C" void kernel_launch(void* const* d_in, const int* in_sizes, int n_in, void* d_out, int out_size, void* d_ws, size_t ws_size, hipStream_t stream) {
    static int grid = 0;
    if (grid == 0) {
        if (n_in != 20 || out_size != NB * SEQ * D || ws_size < WS_END) { fprintf(stderr, "kernel_launch: unexpected shapes / workspace (%d inputs, out %d, ws %zu < %zu)\n", n_in, out_size, ws_size, (size_t)WS_END); grid = -1; return; }
        int dev = 0, cus = 0, per_cu = 0;
        if (hipGetDevice(&dev) != hipSuccess || hipDeviceGetAttribute(&cus, hipDeviceAttributeMultiprocessorCount, dev) != hipSuccess) { grid = -1; return; }
        if (hipFuncSetAttribute((const void*)fwd_kernel, hipFuncAttributeMaxDynamicSharedMemorySize, LDS_BYTES) != hipSuccess) { fprintf(stderr, "kernel_launch: hipFuncSetAttribute failed\n"); grid = -1; return; }
        if (hipOccupancyMaxActiveBlocksPerMultiprocessor(&per_cu, (const void*)fwd_kernel, 512, LDS_BYTES) != hipSuccess || per_cu < 1) { fprintf(stderr, "kernel_launch: occupancy query says %d\n", per_cu); }
        (void)hipGetLastError();
        if (cus < 256) { fprintf(stderr, "kernel_launch: built for a 256-CU device (got %d)\n", cus); grid = -1; return; }
        grid = 256;
    }
    if (grid < 0) return;
    (void)hipMemsetAsync((char*)d_ws + WS_CTL, 0, CTL_ZERO_BYTES, stream);
    Args a{};
    for (int i = 0; i < 20; ++i) a.in[i] = (const float*)d_in[i];
    a.out = (float*)d_out; a.ws = (unsigned char*)d_ws;
    hipLaunchKernelGGL(fwd_kernel, dim3(grid), dim3(512), LDS_BYTES, stream, a);
}
```

```cpp
#include <hip/hip_runtime.h>
#include <cstdio>
#include <cstdint>
__device__ __forceinline__ int opaque_tid() { int t = threadIdx.x; asm volatile("" : "+v"(t)); return t; }
namespace pg8 {
#define PG8_LAS __attribute__((address_space(3)))
typedef unsigned short bf16_t;
typedef short bf16x8 __attribute__((ext_vector_type(8)));
typedef float f32x4 __attribute__((ext_vector_type(4)));
typedef unsigned u32x4 __attribute__((ext_vector_type(4)));
constexpr int BM = 256, BK = 64, HALF = 128, HTB = HALF * BK * 2  , STAGE_BYTES = 8 * HTB, NXCD = 8, WGM = 4;

__host__ __device__ __forceinline__ int lds_byte(int r, int c) { const int st = (r >> 4) * 2 + (c >> 5), rr = r & 15, cc = c & 31, ob = rr * 64 + cc * 2; return st * 1024 + (ob ^ (((ob >> 9) & 1) << 5)); }
__host__ __device__ __forceinline__ void stage_rc(int b, int& R, int& C) { const int st = b / 1024, sb = b % 1024, swz = sb ^ (((sb >> 9) & 1) << 5); R = (st >> 1) * 16 + swz / 64; C = (st & 1) * 32 + (swz % 64) / 2; }
__host__ __device__ __forceinline__ int perm32(int rho) { const int n = rho >> 4, i = rho & 15; return 8 * (i >> 2) + 4 * n + (i & 3); }

struct Unit { int pm, pn; };
struct Gemm { const bf16_t* A; const bf16_t* Bt; int M, N, K, lda, ldb; };

struct StaticOrder {
    int nN, np, x, slot, skip;
    __host__ __device__ void init(int M, int N, int G_, int c_, int skip_ = 0) { (void)M; (void)G_; nN = N / BM; skip = skip_ ? 1 : 0; np = 17 - skip; x = c_ & 7; slot = c_ >> 3; }
    __host__ __device__ bool next(int i, Unit& u) const {
        const int lid = i * 32 + slot; if (lid >= np * nN) return false;
        const int g4 = WGM * nN; int g = lid / g4; g = g > 3 ? 3 : g; const int rem = lid - g * g4, gsz = g == 3 ? np - 12 : 4;
        u.pm = 17 * x + skip + 4 * g + rem % gsz; u.pn = rem / gsz; return true;
    }
    __device__ __forceinline__ void a_ready(const Unit&) const {}
    __device__ __forceinline__ void done(const Unit&) const {}
};
template <class Epi, class Sched, bool ALIGN_EPI = false, bool SP2 = false>
__device__ __forceinline__ void gemm_phase(PG8_LAS unsigned char* lds, const Gemm g, const Sched& S, const Epi& E) {
    const int tid = opaque_tid(), wid = __builtin_amdgcn_readfirstlane(tid >> 6), lane = tid & 63, wr = wid >> 2, wc = wid & 3, fr = lane & 15, fq = lane >> 4;
    const int K = g.K, nt = K / BK;
    unsigned voffA[2], voffB[2];
#pragma unroll
    for (int i = 0; i < 2; ++i) { int R, C; stage_rc(tid * 16 + i * 8192, R, C); const int Rb = Epi::PERM ? ((R & ~31) + perm32(R & 31)) : R;
        voffA[i] = (unsigned)(R * g.lda + C) * 2u; voffB[i] = (unsigned)(Rb * g.ldb + C) * 2u; }
    const size_t kstep = (size_t)(BK * 2);
    const size_t hstepA = (size_t)HALF * g.lda * 2, hstepB = (size_t)HALF * g.ldb * 2;
    const size_t tstepA = 2 * hstepA, tstepB = 2 * hstepB;
    const unsigned ldsw = (unsigned)wid * 1024u;
    const int aoff = lds_byte(wr * 64 + fr, fq * 8), boff = lds_byte(wc * 32 + fr, fq * 8);
#define PG8_SA(b, h) (((b) * 2 + (h)) * HTB)
#define PG8_SB(b, h) ((4 + (b) * 2 + (h)) * HTB)
#define PG8_STAGE(bufoff, gbase, voff) do { _Pragma("unroll") for (int _i = 0; _i < 2; ++_i) \
        __builtin_amdgcn_global_load_lds((const unsigned*)((const char*)(gbase) + (voff)[_i]), (PG8_LAS unsigned*)(lds + (bufoff) + ldsw + _i * 8192), 16, 0, 0); } while (0)
#define PG8_LDA(dst, b, h) do { _Pragma("unroll") for (int m = 0; m < 4; ++m) _Pragma("unroll") for (int k = 0; k < 2; ++k) dst[m][k] = *(const PG8_LAS bf16x8*)(lds + PG8_SA(b, h) + aoff + m * 2048 + k * 1024); } while (0)
#define PG8_LDB(dst, b, h) do { _Pragma("unroll") for (int n = 0; n < 2; ++n) _Pragma("unroll") for (int k = 0; k < 2; ++k) dst[n][k] = *(const PG8_LAS bf16x8*)(lds + PG8_SB(b, h) + boff + n * 2048 + k * 1024); } while (0)
#define PG8_MMA(ai, bj, At, Bt) do { __builtin_amdgcn_s_setprio(1); _Pragma("unroll") for (int m = 0; m < 4; ++m) _Pragma("unroll") for (int n = 0; n < 2; ++n) _Pragma("unroll") for (int k = 0; k < 2; ++k) \
        acc[ai][bj][m][n] = __builtin_amdgcn_mfma_f32_16x16x32_bf16(Bt[n][k], At[m][k], acc[ai][bj][m][n], 0, 0, 0); __builtin_amdgcn_s_setprio(0); } while (0)
#define PG8_WAIT_V(n) asm volatile("s_waitcnt vmcnt(" #n ")" ::: "memory")
#define PG8_WAIT_L(n) asm volatile("s_waitcnt lgkmcnt(" #n ")" ::: "memory")
#define PG8_BAR __builtin_amdgcn_s_barrier()
#define PG8_SCHED __builtin_amdgcn_sched_barrier(0)
    Unit cur, nxt; int ui = 0;
    if (!S.next(0, cur)) return;
    f32x4 acc[2][2][4][2];
#pragma unroll
    for (int a = 0; a < 2; ++a)
#pragma unroll
        for (int b = 0; b < 2; ++b)
#pragma unroll
            for (int m = 0; m < 4; ++m)
#pragma unroll
                for (int n = 0; n < 2; ++n) acc[a][b][m][n] = (f32x4){0.f, 0.f, 0.f, 0.f};
    bf16x8 At[4][2], B0[2][2], B1[2][2];
    const char* cA = (const char*)g.A + (size_t)cur.pm * tstepA; const char* cB = (const char*)g.Bt + (size_t)cur.pn * tstepB;
    S.a_ready(cur);
    if constexpr (SP2) {
        PG8_STAGE(PG8_SB(0, 0), cB, voffB); PG8_STAGE(PG8_SB(0, 1), cB + hstepB, voffB); PG8_STAGE(PG8_SA(0, 0), cA, voffA); PG8_STAGE(PG8_SA(0, 1), cA + hstepA, voffA);
        if (wr == 1) PG8_BAR;
        PG8_WAIT_V(2); PG8_BAR;
        PG8_STAGE(PG8_SB(1, 0), cB + kstep, voffB); PG8_STAGE(PG8_SA(1, 0), cA + kstep, voffA); PG8_STAGE(PG8_SB(1, 1), cB + hstepB + kstep, voffB);
        PG8_WAIT_V(6); PG8_BAR;
    } else {
        PG8_STAGE(PG8_SB(0, 0), cB, voffB); PG8_STAGE(PG8_SA(0, 0), cA, voffA); PG8_STAGE(PG8_SB(0, 1), cB + hstepB, voffB); PG8_STAGE(PG8_SA(0, 1), cA + hstepA, voffA);
        if (wr == 1) PG8_BAR;
        PG8_WAIT_V(4); PG8_BAR;
        PG8_STAGE(PG8_SB(1, 0), cB + kstep, voffB); PG8_STAGE(PG8_SA(1, 0), cA + kstep, voffA); PG8_STAGE(PG8_SB(1, 1), cB + hstepB + kstep, voffB);
        PG8_WAIT_V(6); PG8_BAR;
    }
    for (;;) {
        const bool has_next = S.next(ui + 1, nxt);
        const char* nA = has_next ? (const char*)g.A + (size_t)nxt.pm * tstepA : cA; const char* nB = has_next ? (const char*)g.Bt + (size_t)nxt.pn * tstepB : cB;
        for (int t = 0; t < nt; t += 2) {
            const bool last = (t == nt - 2);
            const char* a1 = cA + (size_t)(t + 1) * kstep;
            const char* a2 = last ? nA : cA + (size_t)(t + 2) * kstep; const char* b2 = last ? nB : cB + (size_t)(t + 2) * kstep;
            const char* a3 = a2 + kstep; const char* b3 = b2 + kstep;
            if (last && has_next) S.a_ready(nxt);
            if constexpr (SP2) {
            PG8_LDB(B0, 0, 0); PG8_LDB(B1, 0, 1); PG8_SCHED; PG8_LDA(At, 0, 0); PG8_STAGE(PG8_SA(1, 1), a1 + hstepA, voffA);
            PG8_WAIT_V(8); PG8_WAIT_L(0); PG8_BAR; PG8_MMA(0, 0, At, B0); PG8_MMA(0, 1, At, B1); PG8_BAR; PG8_SCHED;
            PG8_LDA(At, 0, 1); PG8_STAGE(PG8_SB(0, 0), b2, voffB); PG8_STAGE(PG8_SB(0, 1), b2 + hstepB, voffB); PG8_STAGE(PG8_SA(0, 0), a2, voffA);
            PG8_WAIT_V(8); PG8_WAIT_L(0); PG8_BAR; PG8_MMA(1, 0, At, B0); PG8_MMA(1, 1, At, B1); PG8_BAR; PG8_SCHED;
            PG8_LDB(B0, 1, 0); PG8_LDB(B1, 1, 1); PG8_SCHED; PG8_LDA(At, 1, 0); PG8_STAGE(PG8_SA(0, 1), a2 + hstepA, voffA);
            PG8_WAIT_V(8); PG8_WAIT_L(0); PG8_BAR; PG8_MMA(0, 0, At, B0); PG8_MMA(0, 1, At, B1); PG8_BAR; PG8_SCHED;
            PG8_LDA(At, 1, 1); PG8_STAGE(PG8_SB(1, 0), b3, voffB); PG8_STAGE(PG8_SB(1, 1), b3 + hstepB, voffB); PG8_STAGE(PG8_SA(1, 0), a3, voffA);
            PG8_WAIT_V(8); PG8_WAIT_L(0); PG8_BAR; PG8_MMA(1, 0, At, B0); PG8_MMA(1, 1, At, B1); PG8_BAR; PG8_SCHED;
            if constexpr (Epi::HOOK) { if (t + 2 == Epi::HOOK_T0 || t + 2 == Epi::HOOK_T1) E.hook(acc, cur, t + 2, wr, wc, fr, fq); }
            } else {
            PG8_LDB(B0, 0, 0); PG8_SCHED; PG8_LDA(At, 0, 0); PG8_STAGE(PG8_SA(1, 1), a1 + hstepA, voffA);
            PG8_WAIT_L(8); PG8_BAR; PG8_WAIT_L(0); PG8_MMA(0, 0, At, B0); PG8_BAR; PG8_SCHED;
            PG8_LDB(B1, 0, 1); PG8_STAGE(PG8_SB(0, 0), b2, voffB);
            PG8_BAR; PG8_WAIT_L(0); PG8_MMA(0, 1, At, B1); PG8_BAR;
            PG8_LDA(At, 0, 1); PG8_STAGE(PG8_SA(0, 0), a2, voffA);
            PG8_BAR; PG8_WAIT_L(0); PG8_MMA(1, 0, At, B0); PG8_BAR; PG8_SCHED;
            PG8_STAGE(PG8_SB(0, 1), b2 + hstepB, voffB);
            PG8_WAIT_V(6); PG8_BAR; PG8_MMA(1, 1, At, B1); PG8_BAR;
            PG8_LDB(B0, 1, 0); PG8_SCHED; PG8_LDA(At, 1, 0); PG8_STAGE(PG8_SA(0, 1), a2 + hstepA, voffA);
            PG8_WAIT_L(8); PG8_BAR; PG8_WAIT_L(0); PG8_MMA(0, 0, At, B0); PG8_BAR; PG8_SCHED;
            PG8_LDB(B1, 1, 1); PG8_STAGE(PG8_SB(1, 0), b3, voffB);
            PG8_BAR; PG8_WAIT_L(0); PG8_MMA(0, 1, At, B1); PG8_BAR;
            PG8_LDA(At, 1, 1); PG8_STAGE(PG8_SA(1, 0), a3, voffA);
            PG8_BAR; PG8_WAIT_L(0); PG8_MMA(1, 0, At, B0); PG8_BAR; PG8_SCHED;
            PG8_STAGE(PG8_SB(1, 1), b3 + hstepB, voffB);
            PG8_WAIT_V(6); PG8_BAR; PG8_MMA(1, 1, At, B1); PG8_BAR;
            }
        }
        if constexpr (ALIGN_EPI) { if (wr == 0) PG8_BAR; }
        if constexpr (!Epi::AFTER_DRAIN) { E(acc, cur, wr, wc, fr, fq); S.done(cur); }
        if (!has_next) break;
#pragma unroll
        for (int a = 0; a < 2; ++a)
#pragma unroll
            for (int b = 0; b < 2; ++b)
#pragma unroll
                for (int m = 0; m < 4; ++m)
#pragma unroll
                    for (int n = 0; n < 2; ++n) acc[a][b][m][n] = (f32x4){0.f, 0.f, 0.f, 0.f};
        cur = nxt; cA = nA; cB = nB; ++ui;
        if constexpr (ALIGN_EPI) { if (wr == 1) PG8_BAR; }
    }
    PG8_WAIT_V(0);
    if constexpr (!ALIGN_EPI) { if (wr == 0) PG8_BAR; }
    PG8_BAR;
    if constexpr (Epi::AFTER_DRAIN) { E.fused(acc, cur, wr, wc, fr, fq, lds, wid, lane); S.done(cur); }
#undef PG8_SA
#undef PG8_SB
#undef PG8_STAGE
#undef PG8_LDA
#undef PG8_LDB
#undef PG8_MMA
#undef PG8_WAIT_V
#undef PG8_WAIT_L
#undef PG8_BAR
#undef PG8_SCHED
}
}

constexpr int D = 2048, NB = 8, SEQ = 4096, CTXL = 256, TOK = SEQ + CTXL, M = NB * TOK, DFF = 5632, NL = 4, NMOD = 9, MODW = NMOD * D;
constexpr int INW = 17424, INP = 17664;
constexpr int PA_LD = 4096, PB_LD = 5120, PC_LD = 2048, PG_LD = 6144;
constexpr float EPS = 1e-6f;
constexpr size_t MiB = 1u << 20;
constexpr size_t WS_CTL = 0, CTL_ZERO_BYTES = MiB;
constexpr size_t WS_MODS = 1 * MiB, WS_LB = 4 * MiB, WS_W1T = 5 * MiB, WS_W2T = 93 * MiB, WS_WINT = 137 * MiB, WS_WBRT = 206 * MiB, WS_WOT = 218 * MiB,
                 WS_HC = 226 * MiB, WS_GT = 242 * MiB, WS_XN = 245 * MiB, WS_PA = 381 * MiB, WS_PB = 653 * MiB, WS_PC = 993 * MiB, WS_PG = 1129 * MiB,
                 WS_SO = 1537 * MiB, WS_GTB = 1945 * MiB, WS_Y = 1962 * MiB, WS_WSET2 = 2098 * MiB, WS_Y3 = 2319 * MiB, WS_END = 2523 * MiB;
constexpr size_t SO_STRIDE = (size_t)M * 1024;
static_assert((size_t)M * DFF * 2 <= 6 * SO_STRIDE * 2, "hidden overlay");
constexpr int CW_BAR = 4096, CW_Q = 8192, CW_GBAR = 16384;
constexpr size_t WSET_STRIDE = WS_WSET2 - WS_W1T;
constexpr int RING_BYTES = 131072, LDSCTL_OFF = RING_BYTES, LDS_BYTES = 147456;

#define GAS __attribute__((address_space(1)))
#define LAS __attribute__((address_space(3)))
typedef unsigned short bf16;
typedef unsigned v4u __attribute__((ext_vector_type(4)));
typedef unsigned v2u __attribute__((ext_vector_type(2)));
typedef float f32x4 __attribute__((ext_vector_type(4)));
typedef float f32x2 __attribute__((ext_vector_type(2)));
using pg8::Unit;

typedef __bf16 bf16x2_t __attribute__((ext_vector_type(2)));
__device__ __forceinline__ unsigned cvt_pk_bf16(float lo, float hi) { f32x2 v = {lo, hi}; bf16x2_t r = __builtin_convertvector(v, bf16x2_t); return __builtin_bit_cast(unsigned, r); }
__device__ __forceinline__ float bflo(unsigned w) { return __uint_as_float(w << 16); }
__device__ __forceinline__ float bfhi(unsigned w) { return __uint_as_float(w & 0xffff0000u); }
__device__ __forceinline__ float bf1(bf16 b) { return __uint_as_float(((unsigned)b) << 16); }
__device__ __forceinline__ float sigmoid_f(float x) { return __builtin_amdgcn_rcpf(1.0f + __builtin_amdgcn_exp2f(-1.44269504f * x)); }
__device__ __forceinline__ float silu_f(float x) { return x * sigmoid_f(x); }
__device__ __forceinline__ float gelu_tanh_f(float x) { return x * sigmoid_f(1.5957691216f * (x + 0.044715f * x * x * x)); }
#define DPPF(old, src, ctrl, rmask) __int_as_float(__builtin_amdgcn_update_dpp(__float_as_int(old), __float_as_int(src), (ctrl), (rmask), 0xf, false))
__device__ __forceinline__ float wave_prefix_sum(float v) {
    v += DPPF(0.f, v, 0x111, 0xf); v += DPPF(0.f, v, 0x112, 0xf); v += DPPF(0.f, v, 0x114, 0xf); v += DPPF(0.f, v, 0x118, 0xf);
    v += DPPF(0.f, v, 0x142, 0xa); v += DPPF(0.f, v, 0x143, 0xc); return v; }
__device__ __forceinline__ float wave_prefix_max(float v) { const float ninf = -__builtin_inff();
    v = fmaxf(v, DPPF(ninf, v, 0x111, 0xf)); v = fmaxf(v, DPPF(ninf, v, 0x112, 0xf)); v = fmaxf(v, DPPF(ninf, v, 0x114, 0xf)); v = fmaxf(v, DPPF(ninf, v, 0x118, 0xf));
    v = fmaxf(v, DPPF(ninf, v, 0x142, 0xa)); v = fmaxf(v, DPPF(ninf, v, 0x143, 0xc)); return v; }
__device__ __forceinline__ float wave_sum(float v) { return __int_as_float(__builtin_amdgcn_readlane(__float_as_int(wave_prefix_sum(v)), 63)); }
__device__ __forceinline__ float group8_sum(float v) { v += DPPF(0.f, v, 0xB1, 0xf); v += DPPF(0.f, v, 0x4E, 0xf); v += DPPF(0.f, v, 0x141, 0xf); return v; }
__device__ __forceinline__ float group16_sum(float v) { v = group8_sum(v); v += DPPF(0.f, v, 0x140, 0xf); return v; }
__device__ __forceinline__ void unpack8(const v4u w, float (&f)[8]) { f[0] = bflo(w.x); f[1] = bfhi(w.x); f[2] = bflo(w.y); f[3] = bfhi(w.y); f[4] = bflo(w.z); f[5] = bfhi(w.z); f[6] = bflo(w.w); f[7] = bfhi(w.w); }
__device__ __forceinline__ v4u pack8(const float (&f)[8]) { v4u w; w.x = cvt_pk_bf16(f[0], f[1]); w.y = cvt_pk_bf16(f[2], f[3]); w.z = cvt_pk_bf16(f[4], f[5]); w.w = cvt_pk_bf16(f[6], f[7]); return w; }
#define LDS_WAIT() asm volatile("s_waitcnt lgkmcnt(0)" ::: "memory")
#define PH_IDS const int tid = opaque_tid(), lane = tid & 63, wave = __builtin_amdgcn_readfirstlane(tid >> 6), gw = blockIdx.x * 8 + wave, ngw = gridDim.x * 8; (void)gw; (void)ngw; (void)lane; (void)wave

#define XB_TMO      128
#define XB_XCNT(j)  (256  + 64 * (j))
#define XB_XSUB(j)  (1280 + 64 * (j))
#define XB_XGEN(j)  (2304 + 64 * (j))
#define XB_TOP      3328
#define XB_TOPGEN   3392
#define XCD_BAR_WORDS 3456
#define XB_SPIN_CAP (1u << 18)

__device__ __forceinline__ unsigned xb_ld(unsigned* p)              { return __hip_atomic_load(p, __ATOMIC_RELAXED, __HIP_MEMORY_SCOPE_AGENT); }
__device__ __forceinline__ unsigned xb_add(unsigned* p, unsigned v) { return __hip_atomic_fetch_add(p, v, __ATOMIC_RELAXED, __HIP_MEMORY_SCOPE_AGENT); }
__device__ __forceinline__ unsigned xb_xcc_id() { return (unsigned)__builtin_amdgcn_s_getreg((3 << 11) | 20) & 0xFu; }
#define XB_SPIN(cond, bar) do { unsigned _sp = 0; while (cond) { __builtin_amdgcn_s_sleep(1); \
    if ((++_sp & 255u) == 0u) { if (xb_ld(&(bar)[XB_TMO])) break; if (_sp > XB_SPIN_CAP) { atomicAdd(&(bar)[XB_TMO], 1u); break; } } } } while (0)

struct XcdBarrier {
    unsigned* bar; unsigned x;
    volatile LAS unsigned* st;
};

__device__ __forceinline__ XcdBarrier xcd_barrier_post(unsigned* bar, volatile LAS unsigned* st) {
    XcdBarrier b; b.bar = bar; b.x = xb_xcc_id(); b.st = st;
    if (threadIdx.x == 0) (void)xb_add(&bar[XB_XCNT(b.x)], 1u);
    return b;
}
__device__ __forceinline__ void xcd_barrier_complete(unsigned* bar, unsigned x, unsigned& nloc, unsigned& nx) {
    const unsigned G = gridDim.x * gridDim.y * gridDim.z;
    unsigned sum, cnt, mine, sp = 0u;
    for (;;) {
        sum = 0u; cnt = 0u; mine = 0u;
#pragma unroll
        for (unsigned j = 0; j < 16; ++j) { const unsigned c = xb_ld(&bar[XB_XCNT(j)]); sum += c; cnt += (c > 0u) ? 1u : 0u; mine = (j == x) ? c : mine; }
        if (sum == G) break;
        __builtin_amdgcn_s_sleep(1);
        if ((++sp & 255u) == 0u) { if (xb_ld(&bar[XB_TMO])) break; if (sp > XB_SPIN_CAP) { atomicAdd(&bar[XB_TMO], 1u); break; } }
    }
    nloc = mine > 0u ? mine : 1u; nx = cnt > 0u ? cnt : 1u;
}

__device__ __forceinline__ void xcd_barrier(const XcdBarrier& b) {
    asm volatile("s_waitcnt vmcnt(0)" ::: "memory");
    __syncthreads();
    if (threadIdx.x == 0) {
        unsigned* bar = b.bar;
        __builtin_amdgcn_s_waitcnt(0);
        unsigned nloc = b.st[0], nx = b.st[1];
        if (nloc == 0u) { xcd_barrier_complete(bar, b.x, nloc, nx); b.st[0] = nloc; b.st[1] = nx; }
        const unsigned old = xb_add(&bar[XB_XSUB(b.x)], 1u);
        const unsigned gen = old / nloc;
        if (old + 1u == (gen + 1u) * nloc) {
            __builtin_amdgcn_fence(__ATOMIC_RELEASE, "agent");
            asm volatile("s_waitcnt vmcnt(0)" ::: "memory");
            const unsigned og = xb_add(&bar[XB_TOP], 1u);
            const unsigned tg = og / nx;
            if (og + 1u == (tg + 1u) * nx) xb_add(&bar[XB_TOPGEN], 1u);
            else XB_SPIN(xb_ld(&bar[XB_TOPGEN]) == tg, bar);
            __builtin_amdgcn_fence(__ATOMIC_ACQUIRE, "agent");
            xb_add(&bar[XB_XGEN(b.x)], 1u);
            asm volatile("s_waitcnt vmcnt(0)" ::: "memory");
        } else {
            XB_SPIN(xb_ld(&bar[XB_XGEN(b.x)]) == gen, bar);
            __builtin_amdgcn_fence(__ATOMIC_ACQUIRE, "agent");
            asm volatile("s_waitcnt vmcnt(0)" ::: "memory");
        }
    }
    __syncthreads();
}

#define GB_CNT(c)    (64 * (c))
#define GB_SUB(c)    (8192 + 64 * (c))
#define GB_GEN(c)    (16384 + 64 * (c))
#define GB_TOP(g)    (24576 + 64 * (g))
#define GB_TOPGEN(g) (25088 + 64 * (g))
#define GRP_BAR_WORDS 25600
__device__ __forceinline__ void grp_barrier_post(unsigned* gb) { if (threadIdx.x == 0) (void)xb_add(&gb[GB_CNT(xb_xcc_id() * 8u + ((unsigned)blockIdx.x & 7u))], 1u); }
__device__ __forceinline__ void grp_barrier_census(unsigned* gb, volatile LAS unsigned* st) {
    if (threadIdx.x == 0) {
        const unsigned x = xb_xcc_id(), g = (unsigned)blockIdx.x & 7u; unsigned mine = 0u, cnt = 0u;
#pragma unroll
        for (unsigned j = 0; j < 16; ++j) { const unsigned c = xb_ld(&gb[GB_CNT(j * 8u + g)]); cnt += (c > 0u) ? 1u : 0u; mine = (j == x) ? c : mine; }
        st[2] = mine > 0u ? mine : 1u; st[3] = cnt > 0u ? cnt : 1u;
    }
}
__device__ __forceinline__ void grp_barrier(unsigned* gb, unsigned* bar, volatile LAS unsigned* st) {
    asm volatile("s_waitcnt vmcnt(0)" ::: "memory");
    __syncthreads();
    if (threadIdx.x == 0) {
        __builtin_amdgcn_s_waitcnt(0);
        const unsigned g = (unsigned)blockIdx.x & 7u, cell = xb_xcc_id() * 8u + g, nloc = st[2], nx = st[3];
        const unsigned old = xb_add(&gb[GB_SUB(cell)], 1u);
        const unsigned gen = old / nloc;
        if (old + 1u == (gen + 1u) * nloc) {
            if (nx > 1u) {
                __builtin_amdgcn_fence(__ATOMIC_RELEASE, "agent");
                asm volatile("s_waitcnt vmcnt(0)" ::: "memory");
                const unsigned og = xb_add(&gb[GB_TOP(g)], 1u);
                const unsigned tg = og / nx;
                if (og + 1u == (tg + 1u) * nx) xb_add(&gb[GB_TOPGEN(g)], 1u);
                else XB_SPIN(xb_ld(&gb[GB_TOPGEN(g)]) == tg, bar);
            }
            __builtin_amdgcn_fence(__ATOMIC_ACQUIRE, "agent");
            xb_add(&gb[GB_GEN(cell)], 1u);
            asm volatile("s_waitcnt vmcnt(0)" ::: "memory");
        } else {
            XB_SPIN(xb_ld(&gb[GB_GEN(cell)]) == gen, bar);
            __builtin_amdgcn_fence(__ATOMIC_ACQUIRE, "agent");
            asm volatile("s_waitcnt vmcnt(0)" ::: "memory");
        }
    }
    __syncthreads();
}

#define GB_SUBA(g)    (25600 + 64 * (g))
#define GB_SUBAGEN(g) (26112 + 64 * (g))
#define GB_SUBB(g)    (26624 + 64 * (g))
#define GB_SUBBGEN(g) (27136 + 64 * (g))
__device__ __forceinline__ void sub_barrier(unsigned* gb, unsigned* bar, unsigned cnt_word, unsigned gen_word, unsigned n) {
    asm volatile("s_waitcnt vmcnt(0)" ::: "memory");
    __syncthreads();
    if (threadIdx.x == 0) {
        __builtin_amdgcn_s_waitcnt(0);
        const unsigned old = xb_add(&gb[cnt_word], 1u), gen = old / n;
        if (old + 1u == (gen + 1u) * n) xb_add(&gb[gen_word], 1u);
        else XB_SPIN(xb_ld(&gb[gen_word]) == gen, bar);
        __builtin_amdgcn_fence(__ATOMIC_ACQUIRE, "agent");
        asm volatile("s_waitcnt vmcnt(0)" ::: "memory");
    }
    __syncthreads();
}

struct Args { const float* in[20]; float* out; unsigned char* ws; };
constexpr int TBL_OFF = LDSCTL_OFF + 256;
__device__ __forceinline__ unsigned long long tbl_get(LAS unsigned char* lds, int k) {
    unsigned off = TBL_OFF + 8 * k; asm volatile("" : "+s"(off));
    volatile LAS unsigned* p = (volatile LAS unsigned*)(lds + off); const unsigned lo = __builtin_amdgcn_readfirstlane(p[0]), hi = __builtin_amdgcn_readfirstlane(p[1]);
    return ((unsigned long long)hi << 32) | lo; }
__device__ __forceinline__ const float* inp(LAS unsigned char* lds, int k) { return (const float*)(GAS const float*)tbl_get(lds, k); }
__device__ __forceinline__ float* outp(LAS unsigned char* lds) { return (float*)(GAS float*)tbl_get(lds, 20); }
__device__ __forceinline__ unsigned char* wsp(LAS unsigned char* lds) { return (unsigned char*)(GAS unsigned char*)tbl_get(lds, 21); }

struct EpiStoreBf16 {
    static constexpr bool PERM = true, AFTER_DRAIN = false, HOOK = false; static constexpr int HOOK_T0 = -1, HOOK_T1 = -1;
    bf16* Y;
    __device__ __forceinline__ void operator()(const f32x4 (&acc)[2][2][4][2], const Unit& u, int wr, int wc, int fr, int fq) const {
        bf16* p0 = Y + (size_t)(u.pm * 256 + wr * 64 + fr) * D + u.pn * 256 + wc * 32 + 8 * fq;
#pragma unroll
        for (int ai = 0; ai < 2; ++ai)
#pragma unroll
            for (int m = 0; m < 4; ++m)
#pragma unroll
                for (int bj = 0; bj < 2; ++bj) { const f32x4 a0 = acc[ai][bj][m][0], a1 = acc[ai][bj][m][1]; v4u w;
                    w.x = cvt_pk_bf16(a0.x, a0.y); w.y = cvt_pk_bf16(a0.z, a0.w); w.z = cvt_pk_bf16(a1.x, a1.y); w.w = cvt_pk_bf16(a1.z, a1.w);
                    *(v4u*)(p0 + (size_t)(ai * 128 + m * 16) * D + bj * 128) = w; }
    }
};
struct EpiSwiGLU {
    static constexpr bool PERM = true, AFTER_DRAIN = false, HOOK = false; static constexpr int HOOK_T0 = -1, HOOK_T1 = -1;
    bf16* H;
    __device__ __forceinline__ void operator()(const f32x4 (&acc)[2][2][4][2], const Unit& u, int wr, int wc, int fr, int fq) const {
        const int row0 = u.pm * 256 + wr * 64 + fr, col0 = u.pn * 128 + wc * 32 + 8 * fq;
#pragma unroll
        for (int ai = 0; ai < 2; ++ai)
#pragma unroll
            for (int m = 0; m < 4; ++m) { float o[8];
#pragma unroll
                for (int n = 0; n < 2; ++n)
#pragma unroll
                    for (int q = 0; q < 4; ++q) o[4 * n + q] = silu_f(acc[ai][0][m][n][q]) * acc[ai][1][m][n][q];
                *(v4u*)(H + (size_t)(row0 + ai * 128 + m * 16) * DFF + col0) = pack8(o); }
    }
};
struct EpiInProj {
    static constexpr bool PERM = true, AFTER_DRAIN = false, HOOK = false; static constexpr int HOOK_T0 = -1, HOOK_T1 = -1;
    bf16 *PA, *PB, *PC, *PG, *GTB;
    template <int ACT> __device__ __forceinline__ void run(const f32x4 (&acc)[2][2][4][2], bf16* p0, int ld) const {
#pragma unroll
        for (int ai = 0; ai < 2; ++ai)
#pragma unroll
            for (int m = 0; m < 4; ++m) { bf16* rowp = p0 + (size_t)(ai * 128 + m * 16) * ld;
#pragma unroll
                for (int bj = 0; bj < 2; ++bj) { float o[8];
#pragma unroll
                    for (int n = 0; n < 2; ++n)
#pragma unroll
                        for (int q = 0; q < 4; ++q) { const float v = acc[ai][bj][m][n][q]; o[4 * n + q] = ACT == 0 ? v : ACT == 1 ? v * 0.0625f : ACT == 2 ? sigmoid_f(v) : ACT == 3 ? silu_f(v) : gelu_tanh_f(v); }
                    *(v4u*)(rowp + bj * 128) = pack8(o); }
                asm volatile("" ::: "memory"); }
    }
    __device__ __forceinline__ void operator()(const f32x4 (&acc)[2][2][4][2], const Unit& u, int wr, int wc, int fr, int fq) const {
        const int row0 = u.pm * 256 + wr * 64 + fr;
        const int seg = u.pn >> 2; bf16* base; int ld, cseg;
        if (seg < 4) { base = PA; ld = PA_LD; cseg = seg * 1024; } else if (seg < 9) { base = PB; ld = PB_LD; cseg = (seg - 4) * 1024; }
        else if (seg < 11) { base = PC; ld = PC_LD; cseg = (seg - 9) * 1024; } else if (seg < 17) { base = PG; ld = PG_LD; cseg = (seg - 11) * 1024; } else { base = GTB; ld = 256; cseg = 0; }
        const int act = (seg == 1) ? 1 : (seg == 3 || (seg >= 11 && seg < 17)) ? 2 : (seg == 4 || seg == 8) ? 3 : (seg == 10) ? 4 : 0;
        bf16* p0 = base + (size_t)row0 * ld + cseg + (u.pn & 3) * 256 + wc * 32 + 8 * fq;
        if (act == 0) run<0>(acc, p0, ld); else if (act == 1) run<1>(acc, p0, ld); else if (act == 2) run<2>(acc, p0, ld); else if (act == 3) run<3>(acc, p0, ld); else run<4>(acc, p0, ld);
    }
};
struct EpiBranch {
    static constexpr bool PERM = true, AFTER_DRAIN = false, HOOK = false; static constexpr int HOOK_T0 = -1, HOOK_T1 = -1;
    const bf16* PG; bf16* MG; int br;
    __device__ __forceinline__ void operator()(const f32x4 (&acc)[2][2][4][2], const Unit& u, int wr, int wc, int fr, int fq) const {
        const size_t r0 = (size_t)(u.pm * 256 + wr * 64 + fr); const int col0 = u.pn * 256 + wc * 32 + 8 * fq;
        const bf16* gp0 = PG + r0 * PG_LD + br * 2048 + col0; bf16* mp0 = MG + r0 * D + col0;
#pragma unroll
        for (int ai = 0; ai < 2; ++ai) { v4u gw[4][2], ow[4][2];
#pragma unroll
            for (int m = 0; m < 4; ++m)
#pragma unroll
                for (int bj = 0; bj < 2; ++bj) { const size_t ro = (size_t)(ai * 128 + m * 16); gw[m][bj] = *(const v4u*)(gp0 + ro * PG_LD + bj * 128); ow[m][bj] = (v4u){0u, 0u, 0u, 0u};
                    if (br > 0) ow[m][bj] = *(const v4u*)(mp0 + ro * D + bj * 128); }
#pragma unroll
            for (int m = 0; m < 4; ++m)
#pragma unroll
                for (int bj = 0; bj < 2; ++bj) { const size_t ro = (size_t)(ai * 128 + m * 16); const v4u g = gw[m][bj], o = ow[m][bj]; const f32x4 a0 = acc[ai][bj][m][0], a1 = acc[ai][bj][m][1]; v4u w;
                    w.x = cvt_pk_bf16(bflo(o.x) + bflo(g.x) * a0.x, bfhi(o.x) + bfhi(g.x) * a0.y); w.y = cvt_pk_bf16(bflo(o.y) + bflo(g.y) * a0.z, bfhi(o.y) + bfhi(g.y) * a0.w);
                    w.z = cvt_pk_bf16(bflo(o.z) + bflo(g.z) * a1.x, bfhi(o.z) + bfhi(g.z) * a1.y); w.w = cvt_pk_bf16(bflo(o.w) + bflo(g.w) * a1.z, bfhi(o.w) + bfhi(g.w) * a1.w);
                    *(v4u*)(mp0 + ro * D + bj * 128) = w; }
            asm volatile("" ::: "memory"); }
    }
};

__device__ __forceinline__ void phase_mods(LAS unsigned char* lds, int l0, int l1, int first, int stride, bool do_lb) {
    PH_IDS;
    LAS float* sc = (LAS float*)lds;
    LAS float* red = (LAS float*)(lds + 73728);
    const float* c = inp(lds, 1); const float* cctx = inp(lds, 3); const float* mod_w = inp(lds, 4); const float* mod_b = inp(lds, 5);
    float* mods = (float*)(wsp(lds) + WS_MODS);
    for (int i = tid; i < 9 * 2048; i += 512) { const int mi = i >> 11, k = i & 2047; const float v = mi < 8 ? c[mi * 2048 + k] : cctx[k]; sc[i] = silu_f(v); }
    __syncthreads();
    for (int item = first; item < (l1 - l0) * 144; item += stride) {
        const int l = l0 + item / 144, cb = item % 144; const int col = cb * 128 + 2 * lane;
        const float* wp = mod_w + (size_t)l * D * MODW + (size_t)(wave * 256) * MODW + col;
        float acc[9][2];
#pragma unroll
        for (int mi = 0; mi < 9; ++mi) { acc[mi][0] = 0.f; acc[mi][1] = 0.f; }
        for (int k = 0; k < 256; k += 8) {
            f32x2 wv[8];
#pragma unroll
            for (int u = 0; u < 8; ++u) wv[u] = *(const f32x2*)(wp + (size_t)(k + u) * MODW);
#pragma unroll
            for (int u = 0; u < 8; ++u)
#pragma unroll
                for (int mi = 0; mi < 9; ++mi) { const float s = sc[mi * 2048 + wave * 256 + k + u]; acc[mi][0] += s * wv[u].x; acc[mi][1] += s * wv[u].y; }
        }
#pragma unroll
        for (int mi = 0; mi < 9; ++mi) { red[(wave * 9 + mi) * 128 + 2 * lane] = acc[mi][0]; red[(wave * 9 + mi) * 128 + 2 * lane + 1] = acc[mi][1]; }
        __syncthreads();
        for (int o = tid; o < 9 * 128; o += 512) { const int mi = o >> 7, cc = o & 127; float s = 0.f;
#pragma unroll
            for (int w = 0; w < 8; ++w) s += red[(w * 9 + mi) * 128 + cc];
            mods[((size_t)l * 9 + mi) * MODW + cb * 128 + cc] = s + mod_b[(size_t)l * MODW + cb * 128 + cc]; }
        __syncthreads();
    }
    float* LB = (float*)(wsp(lds) + WS_LB); const float* lg = inp(lds, 11);
    if (do_lb) for (int i = blockIdx.x * 512 + tid; i < 2048; i += gridDim.x * 512) {
        const float x0 = lg[i], x1 = lg[2048 + i], x2 = lg[4096 + i], x3 = lg[6144 + i];
        const float mx = fmaxf(fmaxf(x0, x1), fmaxf(x2, x3));
        const float e0 = expf(x0 - mx), e1 = expf(x1 - mx), e2 = expf(x2 - mx), e3 = expf(x3 - mx), inv = 1.0f / (e0 + e1 + e2 + e3);
        LB[i] = 0.f; LB[2048 + i] = e1 * inv; LB[4096 + i] = (e1 + e2) * inv; LB[6144 + i] = (e1 + e2 + e3) * inv;
    }
}

__device__ __forceinline__ int srccol(int map, int nd) {
    if (map == 0) return nd;
    if (map == 1) { const int t = nd >> 8, w = nd & 255; return w < 128 ? 128 * t + w : 5632 + 128 * t + (w - 128); }
    return nd < 4096 ? nd : nd < 17408 ? nd + 16 : nd < 17424 ? 4096 + (nd - 17408) : -1;
}
__device__ __forceinline__ void transpose_item(const float* W, int N, int ldk, bf16* WT, int nblk, int idx, int map, LAS float* scr, int lane) {
    const int kb = idx / nblk, nb = idx - kb * nblk, k0 = 64 * kb, n0 = 32 * nb;
    const int sc = srccol(map, n0 + (lane & 31));
    float wv[32];
#pragma unroll
    for (int i = 0; i < 32; ++i) wv[i] = sc >= 0 ? W[(size_t)(k0 + 2 * i + (lane >> 5)) * N + sc] : 0.f;
#pragma unroll
    for (int i = 0; i < 32; ++i) scr[(2 * i + (lane >> 5)) * 33 + (lane & 31)] = wv[i];
    LDS_WAIT(); asm volatile("" ::: "memory");
    const int c = lane & 7;
#pragma unroll
    for (int j = 0; j < 4; ++j) { const int n = (lane >> 3) + 8 * j; const LAS float* s = scr + (8 * c) * 33 + n;
        v4u o; o.x = cvt_pk_bf16(s[0 * 33], s[1 * 33]); o.y = cvt_pk_bf16(s[2 * 33], s[3 * 33]); o.z = cvt_pk_bf16(s[4 * 33], s[5 * 33]); o.w = cvt_pk_bf16(s[6 * 33], s[7 * 33]);
        *(v4u*)(WT + (size_t)(n0 + n) * ldk + k0 + 8 * c) = o; }
    LDS_WAIT(); asm volatile("" ::: "memory");
}
constexpr int CV_W1 = 32 * 352, CV_W2 = 88 * 64, CV_WIN = 32 * 552, CV_BR = 16 * 64, CV_WO = 32 * 64, CV_NITEMS = 2 * CV_W1 + 2 * CV_W2 + CV_WIN + 3 * CV_BR + CV_WO;
__device__ __forceinline__ void convert_item(int l, int it, LAS unsigned char* lds, LAS float* scr, int lane) {
    unsigned char* wb = wsp(lds) + (size_t)(l & 1) * WSET_STRIDE;
    bf16* W1T = (bf16*)(wb + WS_W1T); bf16* W2T = (bf16*)(wb + WS_W2T); bf16* WINT = (bf16*)(wb + WS_WINT); bf16* WBRT = (bf16*)(wb + WS_WBRT); bf16* WOT = (bf16*)(wb + WS_WOT);
    int r = it;
    if (r < 2 * CV_W1) { const int s = r / CV_W1; r -= s * CV_W1; transpose_item(inp(lds, 7) + (size_t)(l * 2 + s) * D * (2 * DFF), 2 * DFF, D, W1T + (size_t)s * (2 * DFF) * D, 352, r, 1, scr, lane); return; } r -= 2 * CV_W1;
    if (r < 2 * CV_W2) { const int s = r / CV_W2; r -= s * CV_W2; transpose_item(inp(lds, 8) + (size_t)(l * 2 + s) * DFF * D, D, DFF, W2T + (size_t)s * D * DFF, 64, r, 0, scr, lane); return; } r -= 2 * CV_W2;
    if (r < CV_WIN) { transpose_item(inp(lds, 9) + (size_t)l * D * INW, INW, D, WINT, 552, r, 2, scr, lane); return; } r -= CV_WIN;
    if (r < 3 * CV_BR) { const int s = r / CV_BR; r -= s * CV_BR; transpose_item(inp(lds, 17) + (size_t)(l * 3 + s) * 1024 * D, D, 3072, WBRT + (size_t)s * 1024, 64, r, 0, scr, lane); return; } r -= 3 * CV_BR;
    transpose_item(inp(lds, 18) + (size_t)l * D * D, D, D, WOT, 64, r, 0, scr, lane);
}
__device__ __forceinline__ void convert_in_tail(int l, int h, LAS unsigned char* lds) {
    PH_IDS;
    LAS float* scr = (LAS float*)(lds + wave * 16384);
    const int lo = h * (CV_NITEMS / 2), hi = lo + CV_NITEMS / 2;
    for (int it = lo + ((int)blockIdx.x - 96) * 8 + wave; it < hi; it += 160 * 8) convert_item(l, it, lds, scr, lane);
}
__device__ __forceinline__ void phase_convert(int l, LAS unsigned char* lds) {
    PH_IDS;
    LAS float* scr = (LAS float*)(lds + wave * 16384);
    constexpr int CV_HEAD = 19712;
    if (blockIdx.x >= 144) for (int it = ((int)blockIdx.x - 144) * 8 + wave; it < CV_HEAD; it += 112 * 8) convert_item(l, it, lds, scr, lane);
    for (int it = CV_HEAD + gw; it < CV_NITEMS; it += ngw) convert_item(l, it, lds, scr, lane);
}
struct NormArgs { const float* lat_src; const float* ctx_src; float* lat_dst; float* ctx_dst; const bf16* Y; const float* gate; float coef; const float* g; const float* shift; bf16* XN; float* fin_out; };
__device__ __forceinline__ void norm_one_row(const NormArgs& na, int r, int lane) {
    const int b = r / TOK, t = r - b * TOK; const bool isctx = t < CTXL; const int mi = isctx ? 8 : b;
    if (na.fin_out && isctx) return;
    const size_t ho = isctx ? ((size_t)b * CTXL + t) * D : ((size_t)b * SEQ + (t - CTXL)) * D;
    const float* src = (isctx ? na.ctx_src : na.lat_src) + ho;
    f32x4 v[8], gt[8]; v2u yw[8];
#pragma unroll
    for (int j = 0; j < 8; ++j) v[j] = __builtin_nontemporal_load((const f32x4*)src + lane + 64 * j);
    if (na.Y) { const float* gp = na.gate + (size_t)mi * MODW;
#pragma unroll
        for (int j = 0; j < 8; ++j) { const int c = 4 * lane + 256 * j; yw[j] = __builtin_nontemporal_load((const v2u*)(na.Y + (size_t)r * D + c)); gt[j] = *(const f32x4*)(gp + c); } }
    __builtin_amdgcn_sched_barrier(0);
    if (na.Y) {
#pragma unroll
        for (int j = 0; j < 8; ++j) v[j] += (f32x4){bflo(yw[j].x), bfhi(yw[j].x), bflo(yw[j].y), bfhi(yw[j].y)} * gt[j] * na.coef;
        if (!na.fin_out) { float* dst = (isctx ? na.ctx_dst : na.lat_dst) + ho;
#pragma unroll
            for (int j = 0; j < 8; ++j) __builtin_nontemporal_store(v[j], (f32x4*)dst + lane + 64 * j); } }
    float ss = 0.f;
#pragma unroll
    for (int j = 0; j < 8; ++j) ss += (v[j].x * v[j].x + v[j].y * v[j].y) + (v[j].z * v[j].z + v[j].w * v[j].w);
    if (na.fin_out) { float* p = na.fin_out + ho;
#pragma unroll
        for (int j = 0; j < 8; ++j) gt[j] = *(const f32x4*)(na.g + 4 * lane + 256 * j);
        __builtin_amdgcn_sched_barrier(0);
        const float rstd = 1.0f / sqrtf(wave_sum(ss) * (1.0f / D) + EPS);
#pragma unroll
        for (int j = 0; j < 8; ++j) ((f32x4*)p)[lane + 64 * j] = v[j] * rstd * gt[j];
        return; }
    const float* sh = na.shift + (size_t)mi * MODW; const float* scl = sh + D;
    f32x4 sv[8], hv[8];
#pragma unroll
    for (int j = 0; j < 8; ++j) { const int c = 4 * lane + 256 * j; gt[j] = *(const f32x4*)(na.g + c); sv[j] = *(const f32x4*)(scl + c); hv[j] = *(const f32x4*)(sh + c); }
    __builtin_amdgcn_sched_barrier(0);
    const float rstd = 1.0f / sqrtf(wave_sum(ss) * (1.0f / D) + EPS);
#pragma unroll
    for (int j = 0; j < 8; ++j) { const int c = 4 * lane + 256 * j; const f32x4 y = (v[j] * rstd * gt[j]) * (sv[j] + 1.0f) + hv[j];
        v2u w; w.x = cvt_pk_bf16(y.x, y.y); w.y = cvt_pk_bf16(y.z, y.w); *(v2u*)(na.XN + (size_t)r * D + c) = w; }
}
__device__ __forceinline__ void norm_two_rows(const NormArgs& na, int r0, int r1, int lane) {
    const int b = r0 / TOK, t0 = r0 - b * TOK, t1 = r1 - b * TOK; const bool isctx = t0 < CTXL; const int mi = isctx ? 8 : b;
    const size_t ho0 = isctx ? ((size_t)b * CTXL + t0) * D : ((size_t)b * SEQ + (t0 - CTXL)) * D, ho1 = isctx ? ((size_t)b * CTXL + t1) * D : ((size_t)b * SEQ + (t1 - CTXL)) * D;
    const GAS float* sb = (const GAS float*)(isctx ? na.ctx_src : na.lat_src);
    f32x4 v0[8], v1[8], gt[8]; v2u y0[8], y1[8];
#pragma unroll
    for (int j = 0; j < 8; ++j) { v0[j] = __builtin_nontemporal_load((const GAS f32x4*)(sb + ho0) + lane + 64 * j); v1[j] = __builtin_nontemporal_load((const GAS f32x4*)(sb + ho1) + lane + 64 * j); }
    if (na.Y) { const float* gp = na.gate + (size_t)mi * MODW;
#pragma unroll
        for (int j = 0; j < 8; ++j) { const int c = 4 * lane + 256 * j; y0[j] = __builtin_nontemporal_load((const v2u*)(na.Y + (size_t)r0 * D + c)); y1[j] = __builtin_nontemporal_load((const v2u*)(na.Y + (size_t)r1 * D + c)); gt[j] = *(const f32x4*)(gp + c); } }
    __builtin_amdgcn_sched_barrier(0);
    if (na.Y) {
#pragma unroll
        for (int j = 0; j < 8; ++j) { v0[j] += (f32x4){bflo(y0[j].x), bfhi(y0[j].x), bflo(y0[j].y), bfhi(y0[j].y)} * gt[j] * na.coef; v1[j] += (f32x4){bflo(y1[j].x), bfhi(y1[j].x), bflo(y1[j].y), bfhi(y1[j].y)} * gt[j] * na.coef; }
        GAS float* db = (GAS float*)(isctx ? na.ctx_dst : na.lat_dst);
#pragma unroll
        for (int j = 0; j < 8; ++j) { __builtin_nontemporal_store(v0[j], (GAS f32x4*)(db + ho0) + lane + 64 * j); __builtin_nontemporal_store(v1[j], (GAS f32x4*)(db + ho1) + lane + 64 * j); } }
    float ss0 = 0.f, ss1 = 0.f;
#pragma unroll
    for (int j = 0; j < 8; ++j) { ss0 += (v0[j].x * v0[j].x + v0[j].y * v0[j].y) + (v0[j].z * v0[j].z + v0[j].w * v0[j].w); ss1 += (v1[j].x * v1[j].x + v1[j].y * v1[j].y) + (v1[j].z * v1[j].z + v1[j].w * v1[j].w); }
    const float* sh = na.shift + (size_t)mi * MODW; const float* scl = sh + D;
    const float rstd0 = 1.0f / sqrtf(wave_sum(ss0) * (1.0f / D) + EPS), rstd1 = 1.0f / sqrtf(wave_sum(ss1) * (1.0f / D) + EPS);
#pragma unroll
    for (int jh = 0; jh < 8; jh += 4) { f32x4 gg[4], sv[4], hv[4];
#pragma unroll
        for (int j = 0; j < 4; ++j) { const int c = 4 * lane + 256 * (jh + j); gg[j] = *(const f32x4*)(na.g + c); sv[j] = *(const f32x4*)(scl + c); hv[j] = *(const f32x4*)(sh + c); }
        __builtin_amdgcn_sched_barrier(0);
#pragma unroll
        for (int j = 0; j < 4; ++j) { const int c = 4 * lane + 256 * (jh + j); const f32x4 ya = (v0[jh + j] * rstd0 * gg[j]) * (sv[j] + 1.0f) + hv[j], yb = (v1[jh + j] * rstd1 * gg[j]) * (sv[j] + 1.0f) + hv[j];
            v2u w; w.x = cvt_pk_bf16(ya.x, ya.y); w.y = cvt_pk_bf16(ya.z, ya.w); *(v2u*)(na.XN + (size_t)r0 * D + c) = w;
            v2u x; x.x = cvt_pk_bf16(yb.x, yb.y); x.y = cvt_pk_bf16(yb.z, yb.w); *(v2u*)(na.XN + (size_t)r1 * D + c) = x; }
        __builtin_amdgcn_sched_barrier(0); }
}
__device__ __forceinline__ void norm_rows(const NormArgs& na, int base, int idx0, int step, int lim, int lane) {
    for (int idx = idx0; idx < lim; ) { const int i1 = idx + step;
        if (i1 < lim && !na.fin_out && ((idx < CTXL) == (i1 < CTXL))) { norm_two_rows(na, base + idx, base + i1, lane); idx = i1 + step; }
        else { norm_one_row(na, base + idx, lane); idx = i1; } }
}
constexpr int PO_FULL = 4, PO_TAILSLOTS = 8, PO_READYP = 16;
constexpr int WO_FULL = 3, WO_TAILSLOTS = 20, WO_READYP = 12;
__device__ __forceinline__ void norm_all(const NormArgs& na) { PH_IDS; const int gx = (int)blockIdx.x & 7, wl = ((int)blockIdx.x >> 3) * 8 + wave; norm_rows(na, TOK * gx, wl, 256, TOK, lane); }
__device__ __forceinline__ void norm_ready(const NormArgs& na, int tailslots = PO_TAILSLOTS, int readyp = PO_READYP) {
    PH_IDS;
    const int gx = (int)blockIdx.x & 7, wi = (((int)blockIdx.x >> 3) - tailslots) * 8 + wave, nw = (32 - tailslots) * 8;
    norm_rows(na, TOK * gx, wi, nw, readyp * 256, lane);
}
__device__ __forceinline__ void norm_tail(const NormArgs& na, int readyp = PO_READYP) {
    PH_IDS;
    const int gx = (int)blockIdx.x & 7, wl = ((int)blockIdx.x >> 3) * 8 + wave;
    norm_rows(na, TOK * gx, readyp * 256 + wl, 256, TOK, lane);
}
__device__ __forceinline__ void norm_span(const NormArgs& na, bool tailwg, int tailslots, int readyp) {
    PH_IDS;
    const int gx = (int)blockIdx.x & 7, slot = (int)blockIdx.x >> 3;
    const int idx0 = tailwg ? readyp * 256 + slot * 8 + wave : (slot - tailslots) * 8 + wave, step = tailwg ? tailslots * 8 : (32 - tailslots) * 8, lim = tailwg ? TOK : readyp * 256;
    norm_rows(na, TOK * gx, idx0, step, lim, lane);
}
struct PanelOrder {
    int c, j0, stride, n;
    __device__ __forceinline__ bool next(int i, Unit& u) const { if (i >= n) return false; const int j = j0 + stride * i + (c >> 3); if (j >= 136) return false; u.pm = 17 * (c & 7) + (j >> 3); u.pn = j & 7; return true; }
    __device__ __forceinline__ void a_ready(const Unit&) const {}
    __device__ __forceinline__ void done(const Unit&) const {}
};
__device__ __forceinline__ void phase_fin(bf16* PA, bf16* PB, bf16* PC, const bf16* SO, bf16* Y3) {
    PH_IDS;
    const int gx = (int)blockIdx.x & 7, wl = ((int)blockIdx.x >> 3) * 8 + wave;
    for (int r = TOK * gx + wl; r < TOK * (gx + 1); r += 256) {
        const int c0 = 16 * lane; const size_t so = (size_t)r * 1024 + c0;
        v4u w[3][6];
        const bf16* gsrc[3] = {PA + (size_t)r * PA_LD + 3072 + c0, PB + (size_t)r * PB_LD + 4096 + c0, PC + (size_t)r * PC_LD + 1024 + c0};
#pragma unroll
        for (int br = 0; br < 3; ++br) { const bf16* f = SO + (size_t)(2 * br) * SO_STRIDE + so;
            w[br][0] = *(const v4u*)f; w[br][1] = *(const v4u*)(f + 8); w[br][2] = *(const v4u*)(f + SO_STRIDE); w[br][3] = *(const v4u*)(f + SO_STRIDE + 8);
            w[br][4] = *(const v4u*)gsrc[br]; w[br][5] = *(const v4u*)(gsrc[br] + 8); }
        __builtin_amdgcn_sched_barrier(0);
#pragma unroll
        for (int br = 0; br < 3; ++br) { float s[16], t[16], g[16];
            unpack8(w[br][0], *(float(*)[8])&s[0]); unpack8(w[br][1], *(float(*)[8])&s[8]); unpack8(w[br][2], *(float(*)[8])&t[0]); unpack8(w[br][3], *(float(*)[8])&t[8]);
            unpack8(w[br][4], *(float(*)[8])&g[0]); unpack8(w[br][5], *(float(*)[8])&g[8]);
            float ss = 0.f;
#pragma unroll
            for (int q = 0; q < 16; ++q) { s[q] += t[q]; ss += s[q] * s[q]; }
            float rs = 1.0f;
            if (br == 0) rs = 1.0f / sqrtf(group16_sum(ss) * (1.0f / 256.0f) + EPS);
            if (br == 1) rs = 1.0f / sqrtf(group8_sum(ss) * (1.0f / 128.0f) + EPS);
#pragma unroll
            for (int q = 0; q < 16; ++q) s[q] = s[q] * rs * g[q];
            bf16* y3 = Y3 + (size_t)r * 3072 + 1024 * br + c0; *(v4u*)y3 = pack8(*(float(*)[8])&s[0]); *(v4u*)(y3 + 8) = pack8(*(float(*)[8])&s[8]); }
    }
}

__device__ __forceinline__ int chunk_lo(int rowbase, int dir, int c) { return dir == 0 ? rowbase + 64 * c : (c < 4 ? rowbase + (CTXL - 64) - 64 * c : rowbase + (2 * CTXL + SEQ - 64) - 64 * c); }
__device__ __forceinline__ int chunk_po(int dir, int p) { return dir ? 63 - p : p; }
__device__ __forceinline__ int scan_row(int rowbase, int dir, int s) { return dir == 0 ? rowbase + s : (s < CTXL ? rowbase + (CTXL - 1) - s : rowbase + (2 * CTXL + SEQ - 1) - s); }

typedef short s16x4 __attribute__((ext_vector_type(4)));
typedef pg8::bf16x8 bfx8;
#define MFMA16(a, b, c) __builtin_amdgcn_mfma_f32_16x16x32_bf16((a), (b), (c), 0, 0, 0)
constexpr int ML_KS = 0, KS_LD = 264, ML_CT = 33792, CT_LD = 264, ML_VT = 76032, VT_LD = 72, ML_SS = 87552, SS_LD = 72, ML_OS = 96768;
__device__ __forceinline__ bfx8 ldfrag(const LAS unsigned char* p) { return *(const LAS bfx8*)p; }
__device__ __forceinline__ unsigned short bf16_1(float x) { return (unsigned short)(cvt_pk_bf16(x, 0.f) & 0xffffu); }
constexpr int ML_GT = 104960;
__device__ __forceinline__ void scan_mlstm2(int item, int l, LAS unsigned char* lds) {
    PH_IDS;
    const int es = item & 3, dir = (item >> 2) & 1, hh = (item >> 3) & 3, b = item >> 5, rowbase = b * TOK;
    const bf16* PA = (const bf16*)(wsp(lds) + WS_PA); const bf16* GTB = (const bf16*)(wsp(lds) + WS_GTB); bf16* out = (bf16*)(wsp(lds) + WS_SO) + (size_t)dir * SO_STRIDE;
    const float bi = inp(lds, 10)[((l * 2 + dir) * 2 + 0) * 4 + hh], bfg = inp(lds, 10)[((l * 2 + dir) * 2 + 1) * 4 + hh];
    const int fr = lane & 15, fq = lane >> 4, gsel = wave >> 2, tt = gsel ? 3 - (wave & 3) : (wave & 3);
    LAS unsigned char* Ks = lds + ML_KS; LAS unsigned char* CT = lds + ML_CT; LAS unsigned char* VT = lds + ML_VT; LAS unsigned char* Ss = lds + ML_SS; LAS bf16* Os = (LAS bf16*)(lds + ML_OS);
    LAS float* GT = (LAS float*)(lds + ML_GT);
    constexpr int NC = TOK / 64;
    __syncthreads();
    for (int i = tid; i < (42240 + 11520) / 16; i += 512) *(LAS v4u*)(CT + 16 * i) = (v4u){0u, 0u, 0u, 0u};
    f32x4 Cacc[2][5];
#pragma unroll
    for (int i = 0; i < 2; ++i)
#pragma unroll
        for (int e = 0; e < 5; ++e) Cacc[i][e] = (f32x4){0.f, 0.f, 0.f, 0.f};
    float m_prev = 0.f;
    v4u qf[8], kp[4], vp; float gi_n = 0.f, gf_n = 0.f;
    const int ml_goff = chunk_po(dir, lane) * 256 + dir * 8 + hh;
#define ML_GLOAD(cn) do { const bf16* gp = GTB + (size_t)chunk_lo(rowbase, dir, (cn)) * 256 + ml_goff; gi_n = bf1(gp[0]); gf_n = bf1(gp[4]); } while (0)
#define ML_GATES(cn) do { LAS float* gt = GT + ((cn) & 1) * 320; \
        const float gi = gi_n + bi, gf = gf_n + bfg, lf = fminf(gf, 0.f) - 0.69314718f * __builtin_amdgcn_logf(1.0f + __builtin_amdgcn_exp2f(-1.44269504f * fabsf(gf))); \
        const float bc = wave_prefix_sum(lf), av = gi - bc, pm = wave_prefix_max(av); \
        const float mx = fmaxf(m_prev, pm), mx63 = __int_as_float(__builtin_amdgcn_readlane(__float_as_int(mx), 63)), b63 = __int_as_float(__builtin_amdgcn_readlane(__float_as_int(bc), 63)); \
        gt[lane] = __builtin_amdgcn_exp2f(1.44269504f * (m_prev - mx)); gt[64 + lane] = __builtin_amdgcn_exp2f(1.44269504f * (mx63 - mx)); gt[128 + lane] = __builtin_amdgcn_exp2f(-1.44269504f * (bc + mx)); \
        gt[192 + lane] = __builtin_amdgcn_exp2f(1.44269504f * (av - mx63)); gt[256 + lane] = __builtin_amdgcn_exp2f(1.44269504f * (m_prev - mx63)); m_prev = b63 + mx63; } while (0)
    const int ml_koff = (dir ? 15 - (tid >> 5) : (tid >> 5)) * PA_LD + 1024 + hh * 256 + 8 * (tid & 31), ml_voff = chunk_po(dir, lane) * PA_LD + 2048 + hh * 256 + es * 64 + 8 * wave;
    const int ml_qoff = chunk_po(dir, 16 * tt + fr) * PA_LD + hh * 256 + 8 * fq, ml_ooff = chunk_po(dir, tid >> 3) * 1024 + hh * 256 + es * 64 + 8 * (tid & 7);
#define ML_LOAD(cn) do { const bf16* cb = PA + (size_t)chunk_lo(rowbase, dir, (cn)) * PA_LD; \
        _Pragma("unroll") for (int i = 0; i < 4; ++i) kp[i] = *(const v4u*)(cb + (size_t)((dir ? 48 - 16 * i : 16 * i) * PA_LD) + ml_koff); \
        vp = *(const v4u*)(cb + ml_voff); } while (0)
#define ML_LOADQ(cn) do { const bf16* qp = PA + (size_t)chunk_lo(rowbase, dir, (cn)) * PA_LD + ml_qoff; _Pragma("unroll") for (int ks = 0; ks < 8; ++ks) qf[ks] = *(const v4u*)(qp + 32 * ks); } while (0)
#define ML_STAGE(cn) do { const float bs = GT[((cn) & 1) * 320 + 192 + olane]; \
        { LAS unsigned char* ksp = Ks + (((otid >> 5) * KS_LD) + 8 * (otid & 31)) * 2; _Pragma("unroll") for (int i = 0; i < 4; ++i) *(LAS v4u*)(ksp + i * (16 * KS_LD * 2)) = kp[i]; } \
        { LAS unsigned char* vtp = VT + ((8 * wave) * VT_LD + olane) * 2; float v[8]; unpack8(vp, v); \
          _Pragma("unroll") for (int i = 0; i < 8; i += 2) { const unsigned pk = cvt_pk_bf16(bs * v[i], bs * v[i + 1]); *(LAS unsigned short*)(vtp + i * (VT_LD * 2)) = (unsigned short)pk; *(LAS unsigned short*)(vtp + (i + 1) * (VT_LD * 2)) = (unsigned short)(pk >> 16); } \
          LAS unsigned char* vap = VT + ((64 + 2 * wave) * VT_LD + olane) * 2; const unsigned short b1 = bf16_1(bs); *(LAS unsigned short*)vap = b1; *(LAS unsigned short*)(vap + VT_LD * 2) = b1; } } while (0)
    int otid = tid, olane = lane;
    ML_LOAD(0); ML_LOADQ(0);
    if (wave == 7) { ML_GLOAD(0); ML_GATES(0); ML_GLOAD(1); }
    __syncthreads();
    ML_STAGE(0);
    for (int c = 0; c < NC; ++c) {
        __syncthreads();
        otid = tid; asm volatile("" : "+v"(otid)); olane = otid & 63;
        if (c > 0) *(v4u*)(out + (size_t)chunk_lo(rowbase, dir, c - 1) * 1024 + ml_ooff) = *(const LAS v4u*)(Os + (otid >> 3) * 64 + 8 * (otid & 7));
        if (c + 1 < NC) ML_LOAD(c + 1);
        if (wave == 7 && c + 1 < NC) { ML_GATES(c + 1); if (c + 2 < NC) ML_GLOAD(c + 2); }
        v2u spk[2];
#pragma unroll
        for (int si = 0; si < 2; ++si) { const int st = 2 * gsel + si; spk[si] = (v2u){0u, 0u};
            if (st <= tt) { f32x4 acc = (f32x4){0.f, 0.f, 0.f, 0.f}, acc2 = (f32x4){0.f, 0.f, 0.f, 0.f};
#pragma unroll
                for (int kh = 0; kh < 2; ++kh) { bfx8 kf[4];
#pragma unroll
                    for (int k4 = 0; k4 < 4; ++k4) kf[k4] = ldfrag(Ks + ((16 * st + fr) * KS_LD + 32 * (4 * kh + k4) + 8 * fq) * 2);
                    __builtin_amdgcn_sched_barrier(0);
#pragma unroll
                    for (int k4 = 0; k4 < 4; k4 += 2) { acc = MFMA16(kf[k4], __builtin_bit_cast(bfx8, qf[4 * kh + k4]), acc); acc2 = MFMA16(kf[k4 + 1], __builtin_bit_cast(bfx8, qf[4 * kh + k4 + 1]), acc2); }
                    __builtin_amdgcn_sched_barrier(0); }
                acc += acc2;
                if (st == tt) {
#pragma unroll
                    for (int j = 0; j < 4; ++j) if (4 * fq + j > fr) acc[j] = 0.f; }
                spk[si].x = cvt_pk_bf16(acc[0], acc[1]); spk[si].y = cvt_pk_bf16(acc[2], acc[3]); } }
        f32x4 N1[3], N2[3];
#pragma unroll
        for (int x = 0; x < 3; ++x) { N1[x] = (f32x4){0.f, 0.f, 0.f, 0.f}; N2[x] = (f32x4){0.f, 0.f, 0.f, 0.f}; }
#pragma unroll
        for (int ks = 0; ks < 8; ++ks) { bfx8 cf[3];
#pragma unroll
            for (int x = 0; x < 3; ++x) { const int et = (x < 2) ? 2 * gsel + x : 4; cf[x] = ldfrag(CT + ((16 * et + fr) * CT_LD + 32 * ks + 8 * fq) * 2); }
            __builtin_amdgcn_sched_barrier(0);
#pragma unroll
            for (int x = 0; x < 3; ++x) N1[x] = MFMA16(__builtin_bit_cast(bfx8, qf[ks]), cf[x], N1[x]);
            __builtin_amdgcn_sched_barrier(0); }
#pragma unroll
        for (int si = 0; si < 2; ++si) *(LAS v2u*)(Ss + ((16 * tt + fr) * SS_LD + 16 * (2 * gsel + si) + 4 * fq) * 2) = spk[si];
        __syncthreads();
        if (c + 1 < NC) ML_LOADQ(c + 1);
#pragma unroll
        for (int ks = 0; ks < 2; ++ks) if (ks == 0 || tt >= 2) { bfx8 vf[3];
            const bfx8 sf = ldfrag(Ss + ((16 * tt + fr) * SS_LD + 32 * ks + 8 * fq) * 2);
#pragma unroll
            for (int x = 0; x < 3; ++x) { const int et = (x < 2) ? 2 * gsel + x : 4; vf[x] = ldfrag(VT + ((16 * et + fr) * VT_LD + 32 * ks + 8 * fq) * 2); }
            __builtin_amdgcn_sched_barrier(0);
#pragma unroll
            for (int x = 0; x < 3; ++x) N2[x] = MFMA16(sf, vf[x], N2[x]);
            __builtin_amdgcn_sched_barrier(0); }
        { bfx8 Af[2][2]; const float decay_c = GT[(c & 1) * 320 + 256];
#pragma unroll
            for (int i = 0; i < 2; ++i)
#pragma unroll
                for (int ks = 0; ks < 2; ++ks) { LAS unsigned char* ap = Ks + ((32 * ks + 8 * fq + (fr >> 2)) * KS_LD + 16 * (2 * wave + i) + 4 * (fr & 3)) * 2;
                    const s16x4 r0 = __builtin_amdgcn_ds_read_tr16_b64_v4i16((LAS s16x4*)ap), r1 = __builtin_amdgcn_ds_read_tr16_b64_v4i16((LAS s16x4*)(ap + 4 * KS_LD * 2));
                    Af[i][ks] = (bfx8){r0[0], r0[1], r0[2], r0[3], r1[0], r1[1], r1[2], r1[3]}; }
#pragma unroll
            for (int e = 0; e < 5; ++e)
#pragma unroll
                for (int i = 0; i < 2; ++i) Cacc[i][e] *= decay_c;
#pragma unroll
            for (int ks = 0; ks < 2; ++ks)
#pragma unroll
                for (int eh = 0; eh < 5; eh += 3) { bfx8 vb[3];
#pragma unroll
                    for (int e = eh; e < 5 && e < eh + 3; ++e) vb[e - eh] = ldfrag(VT + ((16 * e + fr) * VT_LD + 32 * ks + 8 * fq) * 2);
                    __builtin_amdgcn_sched_barrier(0);
#pragma unroll
                    for (int e = eh; e < 5 && e < eh + 3; ++e)
#pragma unroll
                        for (int i = 0; i < 2; ++i) Cacc[i][e] = MFMA16(Af[i][ks], vb[e - eh], Cacc[i][e]);
                    __builtin_amdgcn_sched_barrier(0); }
#pragma unroll
            for (int e = 0; e < 5; ++e)
#pragma unroll
                for (int i = 0; i < 2; ++i) { v2u pk; pk.x = cvt_pk_bf16(Cacc[i][e][0], Cacc[i][e][1]); pk.y = cvt_pk_bf16(Cacc[i][e][2], Cacc[i][e][3]);
                    *(LAS v2u*)(CT + ((16 * e + fr) * CT_LD + 16 * (2 * wave + i) + 4 * fq) * 2) = pk; } }
        { const LAS float* gt = GT + (c & 1) * 320 + 16 * tt + 4 * fq; const f32x4 wi4 = *(const LAS f32x4*)gt, al4 = *(const LAS f32x4*)(gt + 64), em4 = *(const LAS f32x4*)(gt + 128);
            float rden[4];
#pragma unroll
            for (int j = 0; j < 4; ++j) rden[j] = wi4[j] * N1[2][j] + al4[j] * N2[2][j];
#pragma unroll
            for (int j = 0; j < 4; ++j) rden[j] = __builtin_amdgcn_rcpf(fmaxf(fabsf(rden[j]), em4[j]));
#pragma unroll
            for (int j = 0; j < 4; ++j) { const int tl = 16 * tt + 4 * fq + j;
#pragma unroll
                for (int x = 0; x < 2; ++x) Os[tl * 64 + 16 * (2 * gsel + x) + fr] = bf16_1((wi4[j] * N1[x][j] + al4[j] * N2[x][j]) * rden[j]); } }
        __syncthreads();
        if (c + 1 < NC) ML_STAGE(c + 1);
    }
    *(v4u*)(out + (size_t)chunk_lo(rowbase, dir, NC - 1) * 1024 + ml_ooff) = *(const LAS v4u*)(Os + (tid >> 3) * 64 + 8 * (tid & 7));
#undef ML_GLOAD
#undef ML_GATES
#undef ML_LOAD
#undef ML_LOADQ
#undef ML_STAGE
}
constexpr int HG_Q = 0, HG_K = 17408, HG_ST = 34816, HG_VT = 52224, HG_SS = 61440, HG_OS = 70656, HG_PART = 81920, HG_ER = 80896, HG_EB = 81408, HQ_LD = 136;
__device__ __forceinline__ void scan_hgrn2(int item, int l, LAS unsigned char* lds) {
    PH_IDS;
    const int half = item & 1, dir = (item >> 1) & 1, hh = (item >> 2) & 7, b = item >> 5, rowbase = b * TOK;
    const bf16* PB = (const bf16*)(wsp(lds) + WS_PB); bf16* out = (bf16*)(wsp(lds) + WS_SO) + (size_t)(2 + dir) * SO_STRIDE;
    const int fr = lane & 15, fq = lane >> 4, tt = wave & 3, gsel = wave >> 2, pd = tid & 127, ptq = tid >> 7;
    const f32x2 lbv2 = *(const f32x2*)((const float*)(wsp(lds) + WS_LB) + (size_t)(l * 2 + dir) * 1024 + hh * 128 + 2 * lane);
    LAS unsigned char* HQ = lds + HG_Q; LAS unsigned char* HK = lds + HG_K; LAS unsigned char* ST = lds + HG_ST; LAS unsigned char* VT = lds + HG_VT; LAS unsigned char* Ss = lds + HG_SS;
    LAS bf16* Os = (LAS bf16*)(lds + HG_OS); LAS float* PART = (LAS float*)(lds + HG_PART); LAS float* ER = (LAS float*)(lds + HG_ER); LAS float* EB = (LAS float*)(lds + HG_EB);
    constexpr int NC = TOK / 64;
    f32x4 Sacc[4];
#pragma unroll
    for (int e = 0; e < 4; ++e) Sacc[e] = (f32x4){0.f, 0.f, 0.f, 0.f};
    v4u fp[2], qp[2], vp;
    const int hg_toff = chunk_po(dir, tid >> 3) * PB_LD + hh * 128 + 16 * (tid & 7), hg_voff = chunk_po(dir, tid >> 3) * PB_LD + 3072 + hh * 128 + half * 64 + 8 * (tid & 7);
    const int hg_ooff = chunk_po(dir, tid >> 3) * 1024 + hh * 128 + half * 64 + 8 * (tid & 7);
#define HG_LOAD(cn) do { const bf16* cb = PB + (size_t)chunk_lo(rowbase, dir, (cn)) * PB_LD; const bf16* rp = cb + hg_toff; \
        qp[0] = *(const v4u*)(rp); qp[1] = *(const v4u*)(rp + 8); fp[0] = *(const v4u*)(rp + (1 + dir) * 1024); fp[1] = *(const v4u*)(rp + (1 + dir) * 1024 + 8); \
        vp = *(const v4u*)(cb + hg_voff); } while (0)
    __syncthreads();
    HG_LOAD(0);
    for (int c = 0; c < NC; ++c) {
        { const int p = tid >> 3, ch = tid & 7;
            *(LAS v4u*)(HQ + (p * HQ_LD + 16 * ch) * 2) = qp[0]; *(LAS v4u*)(HQ + (p * HQ_LD + 16 * ch + 8) * 2) = qp[1];
            *(LAS v4u*)(HK + (p * HQ_LD + 16 * ch) * 2) = fp[0]; *(LAS v4u*)(HK + (p * HQ_LD + 16 * ch + 8) * 2) = fp[1];
            { LAS unsigned char* vtp = VT + ((8 * ch) * VT_LD + p) * 2; const unsigned w4[4] = {vp.x, vp.y, vp.z, vp.w};
#pragma unroll
                for (int i = 0; i < 4; ++i) { *(LAS unsigned short*)(vtp + (2 * i) * (VT_LD * 2)) = (unsigned short)w4[i]; *(LAS unsigned short*)(vtp + (2 * i + 1) * (VT_LD * 2)) = (unsigned short)(w4[i] >> 16); } } }
        if (c + 1 < NC) HG_LOAD(c + 1);
        __builtin_amdgcn_fence(__ATOMIC_RELEASE, "wavefront"); __builtin_amdgcn_wave_barrier();
        f32x2 ff2[8], qq2[8], cs2[8]; f32x2 run2 = (f32x2){0.f, 0.f};
        { const LAS unsigned char* kr = HK + ((8 * wave) * HQ_LD + 2 * lane) * 2; const LAS unsigned char* qr = HQ + ((8 * wave) * HQ_LD + 2 * lane) * 2; const f32x2 oml2 = 1.0f - lbv2;
            unsigned kw[8], qw[8];
#pragma unroll
            for (int i = 0; i < 8; ++i) { kw[i] = *(const LAS unsigned*)(kr + i * (HQ_LD * 2)); qw[i] = *(const LAS unsigned*)(qr + i * (HQ_LD * 2)); }
#pragma unroll
            for (int i = 0; i < 8; ++i) { const f32x2 x2 = (f32x2){bflo(kw[i]), bfhi(kw[i])}; qq2[i] = (f32x2){bflo(qw[i]), bfhi(qw[i])};
                const f32x2 t2 = x2 * -1.44269504f; const f32x2 d2 = (f32x2){__builtin_amdgcn_exp2f(t2.x), __builtin_amdgcn_exp2f(t2.y)} + 1.0f;
                const f32x2 f2 = (f32x2){__builtin_amdgcn_rcpf(d2.x), __builtin_amdgcn_rcpf(d2.y)} * oml2 + lbv2; ff2[i] = f2;
                run2 += (f32x2){fmaxf(__builtin_amdgcn_logf(f2.x), -126.0f), fmaxf(__builtin_amdgcn_logf(f2.y), -126.0f)}; cs2[i] = run2; } }
        *(LAS f32x2*)(PART + wave * 128 + 2 * lane) = run2;
        __syncthreads();
        { f32x2 pg[8];
#pragma unroll
            for (int g = 0; g < 8; ++g) pg[g] = *(const LAS f32x2*)(PART + g * 128 + 2 * lane);
            const f32x2 r = (pg[0] + pg[1]) + (pg[2] + pg[3]), b63 = r + ((pg[4] + pg[5]) + (pg[6] + pg[7]));
            f32x2 before = (f32x2){0.f, 0.f};
#pragma unroll
            for (int g = 0; g < 7; ++g) if (g < wave) before += pg[g];
            const f32x2 offr = before - r;
            LAS unsigned char* qwp = HQ + ((8 * wave) * HQ_LD + 2 * lane) * 2; LAS unsigned char* kwp = HK + ((8 * wave) * HQ_LD + 2 * lane) * 2;
#pragma unroll
            for (int i = 0; i < 8; ++i) { const f32x2 db = cs2[i] + offr; const f32x2 nd = db * -1.0f;
                const f32x2 eq = (f32x2){__builtin_amdgcn_exp2f(fmaxf(db.x, -100.0f)), __builtin_amdgcn_exp2f(fmaxf(db.y, -100.0f))}, ek = (f32x2){__builtin_amdgcn_exp2f(fminf(nd.x, 100.0f)), __builtin_amdgcn_exp2f(fminf(nd.y, 100.0f))};
                const f32x2 qv = qq2[i] * eq, kv = (1.0f - ff2[i]) * ek;
                *(LAS unsigned*)(qwp + i * (HQ_LD * 2)) = cvt_pk_bf16(qv.x, qv.y); *(LAS unsigned*)(kwp + i * (HQ_LD * 2)) = cvt_pk_bf16(kv.x, kv.y); }
            if (wave == 0) { *(LAS f32x2*)(ER + 2 * lane) = (f32x2){__builtin_amdgcn_exp2f(r.x), __builtin_amdgcn_exp2f(r.y)}; *(LAS f32x2*)(EB + 2 * lane) = (f32x2){__builtin_amdgcn_exp2f(b63.x - r.x), __builtin_amdgcn_exp2f(b63.y - r.y)}; } }
        __syncthreads();
        { const f32x4 er4 = *(const LAS f32x4*)(ER + 16 * wave + 4 * fq);
#pragma unroll
            for (int e = 0; e < 4; ++e) { Sacc[e] *= er4; v2u pk; pk.x = cvt_pk_bf16(Sacc[e][0], Sacc[e][1]); pk.y = cvt_pk_bf16(Sacc[e][2], Sacc[e][3]);
                *(LAS v2u*)(ST + ((16 * e + fr) * HQ_LD + 16 * wave + 4 * fq) * 2) = pk; } }
        { bfx8 qfr[4]; v2u spk[2];
#pragma unroll
            for (int ks = 0; ks < 4; ++ks) qfr[ks] = ldfrag(HQ + ((16 * tt + fr) * HQ_LD + 32 * ks + 8 * fq) * 2);
#pragma unroll
            for (int si = 0; si < 2; ++si) { const int st = 2 * gsel + si; spk[si] = (v2u){0u, 0u};
                if (st <= tt) { bfx8 kfr[4];
#pragma unroll
                    for (int ks = 0; ks < 4; ++ks) kfr[ks] = ldfrag(HK + ((16 * st + fr) * HQ_LD + 32 * ks + 8 * fq) * 2);
                    __builtin_amdgcn_sched_barrier(0);
                    f32x4 acc = (f32x4){0.f, 0.f, 0.f, 0.f}, acc2 = (f32x4){0.f, 0.f, 0.f, 0.f};
#pragma unroll
                    for (int ks = 0; ks < 4; ks += 2) { acc = MFMA16(kfr[ks], qfr[ks], acc); acc2 = MFMA16(kfr[ks + 1], qfr[ks + 1], acc2); }
                    acc += acc2;
                    if (st == tt) {
#pragma unroll
                        for (int j = 0; j < 4; ++j) if (4 * fq + j > fr) acc[j] = 0.f; }
                    spk[si].x = cvt_pk_bf16(acc[0], acc[1]); spk[si].y = cvt_pk_bf16(acc[2], acc[3]);
                    __builtin_amdgcn_sched_barrier(0); } }
#pragma unroll
            for (int si = 0; si < 2; ++si) *(LAS v2u*)(Ss + ((16 * tt + fr) * SS_LD + 16 * (2 * gsel + si) + 4 * fq) * 2) = spk[si]; }
        __syncthreads();
        { f32x4 O[2]; O[0] = (f32x4){0.f, 0.f, 0.f, 0.f}; O[1] = (f32x4){0.f, 0.f, 0.f, 0.f};
#pragma unroll
            for (int kh = 0; kh < 2; ++kh) { bfx8 af[2], sf[2][2];
#pragma unroll
                for (int k2 = 0; k2 < 2; ++k2) { af[k2] = ldfrag(HQ + ((16 * tt + fr) * HQ_LD + 32 * (2 * kh + k2) + 8 * fq) * 2);
#pragma unroll
                    for (int x = 0; x < 2; ++x) sf[k2][x] = ldfrag(ST + ((16 * (2 * gsel + x) + fr) * HQ_LD + 32 * (2 * kh + k2) + 8 * fq) * 2); }
                __builtin_amdgcn_sched_barrier(0);
#pragma unroll
                for (int k2 = 0; k2 < 2; ++k2)
#pragma unroll
                    for (int x = 0; x < 2; ++x) O[x] = MFMA16(af[k2], sf[k2][x], O[x]);
                __builtin_amdgcn_sched_barrier(0); }
#pragma unroll
            for (int ks = 0; ks < 2; ++ks) if (ks == 0 || tt >= 2) { bfx8 vf[2]; const bfx8 af = ldfrag(Ss + ((16 * tt + fr) * SS_LD + 32 * ks + 8 * fq) * 2);
#pragma unroll
                for (int x = 0; x < 2; ++x) vf[x] = ldfrag(VT + ((16 * (2 * gsel + x) + fr) * VT_LD + 32 * ks + 8 * fq) * 2);
                __builtin_amdgcn_sched_barrier(0);
#pragma unroll
                for (int x = 0; x < 2; ++x) O[x] = MFMA16(af, vf[x], O[x]);
                __builtin_amdgcn_sched_barrier(0); }
            bfx8 Af[2];
#pragma unroll
            for (int ks = 0; ks < 2; ++ks) { LAS unsigned char* ap = HK + ((32 * ks + 8 * fq + (fr >> 2)) * HQ_LD + 16 * wave + 4 * (fr & 3)) * 2;
                const s16x4 r0 = __builtin_amdgcn_ds_read_tr16_b64_v4i16((LAS s16x4*)ap), r1 = __builtin_amdgcn_ds_read_tr16_b64_v4i16((LAS s16x4*)(ap + 4 * HQ_LD * 2));
                Af[ks] = (bfx8){r0[0], r0[1], r0[2], r0[3], r1[0], r1[1], r1[2], r1[3]}; }
            const f32x4 eb4 = *(const LAS f32x4*)(EB + 16 * wave + 4 * fq);
#pragma unroll
            for (int ks = 0; ks < 2; ++ks) { bfx8 vb[4];
#pragma unroll
                for (int e = 0; e < 4; ++e) vb[e] = ldfrag(VT + ((16 * e + fr) * VT_LD + 32 * ks + 8 * fq) * 2);
                __builtin_amdgcn_sched_barrier(0);
#pragma unroll
                for (int e = 0; e < 4; ++e) Sacc[e] = MFMA16(Af[ks], vb[e], Sacc[e]);
                __builtin_amdgcn_sched_barrier(0); }
#pragma unroll
            for (int e = 0; e < 4; ++e) Sacc[e] *= eb4;
#pragma unroll
            for (int j = 0; j < 4; ++j)
#pragma unroll
                for (int x = 0; x < 2; ++x) Os[(16 * tt + 4 * fq + j) * 64 + 16 * (2 * gsel + x) + fr] = bf16_1(O[x][j]); }
        __syncthreads();
        *(v4u*)(out + (size_t)chunk_lo(rowbase, dir, c) * 1024 + hg_ooff) = *(const LAS v4u*)(Os + (tid >> 3) * 64 + 8 * (tid & 7));
    }
#undef HG_LOAD
}
constexpr int RW_LD = 72;
constexpr int R3_X = 0, R3_UB = 17408, R3_A = 35840, R3_BX = 68608, R3_H = 84992, R3_W = 101376, R3_C = 119808;
__device__ __forceinline__ void scan_rglru3(int item, int l, LAS unsigned char* lds) {
    PH_IDS;
    const int dir = item & 1, blk = (item >> 1) & 15, b = item >> 5, rowbase = b * TOK;
    const bf16* PC = (const bf16*)(wsp(lds) + WS_PC); bf16* out = (bf16*)(wsp(lds) + WS_SO) + (size_t)(4 + dir) * SO_STRIDE;
    LAS unsigned char* Wg = lds + R3_W; LAS float* cst = (LAS float*)(lds + R3_C);
    const int fr = lane & 15, fq = lane >> 4, tt = wave & 3, st_t = tid >> 3, st_c = tid & 7;
    constexpr int NC = TOK / 64;
    __syncthreads();
    { const float* w = inp(lds, 14) + (size_t)((l * 2 + dir) * 2) * 16 * 4096;
#pragma unroll 4
        for (int i = 0; i < 16; ++i) { const int idx = tid + 512 * i, c = idx & 63, k = (idx >> 6) & 63, g = idx >> 12;
            *(LAS unsigned short*)(Wg + ((64 * g + c) * RW_LD + k) * 2) = bf16_1(w[((size_t)g * 16 + blk) * 4096 + k * 64 + c]); }
        if (tid < 64) { const int ch = blk * 64 + tid; cst[tid] = inp(lds, 15)[((l * 2 + dir) * 2 + 0) * 1024 + ch]; cst[64 + tid] = inp(lds, 15)[((l * 2 + dir) * 2 + 1) * 1024 + ch];
            cst[128 + tid] = -8.0f * log1pf(expf(-inp(lds, 16)[(l * 2 + dir) * 1024 + ch])); cst[448 + tid] = inp(lds, 13)[l * 1024 + ch];
#pragma unroll
            for (int tp = 0; tp < 4; ++tp) cst[192 + 64 * tp + tid] = inp(lds, 12)[(l * 4 + tp) * 1024 + ch]; } }
    v4u xp0 = (v4u){0u, 0u, 0u, 0u}, xh0 = xp0, xp1 = xp0, xh1 = xp0, xp2 = xp0, xh2 = xp0;
#define R3_TILE(cn, isctx_, Lseg_, a0_) const bool isctx_ = (cn) < 4; const int Lseg_ = isctx_ ? CTXL : SEQ, a0_ = dir ? (Lseg_ - 64) - 64 * (isctx_ ? (cn) : (cn) - 4) : 64 * (isctx_ ? (cn) : (cn) - 4)
#define R3_ROW(ic, pos) ((ic) ? rowbase + (pos) : rowbase + CTXL + ((pos) & 63) * 64 + ((pos) >> 6))
#define R3_LOAD(cn, xp, xh) do { R3_TILE(cn, ic, Ls, a0); { const int pos = a0 - 2 + st_t; xp = (v4u){0u, 0u, 0u, 0u}; if (pos >= 0 && pos < Ls) xp = *(const v4u*)(PC + (size_t)R3_ROW(ic, pos) * PC_LD + blk * 64 + 8 * st_c); } \
        if (tid < 24) { const int pos = a0 + 62 + st_t; xh = (v4u){0u, 0u, 0u, 0u}; if (pos >= 0 && pos < Ls) xh = *(const v4u*)(PC + (size_t)R3_ROW(ic, pos) * PC_LD + blk * 64 + 8 * st_c); } } while (0)
    R3_LOAD(0, xp0, xh0); R3_LOAD(1, xp1, xh1); R3_LOAD(2, xp2, xh2);
    float hstate = 0.f;
    __syncthreads();
    f32x4 cw[4][2], cbias[2];
#pragma unroll
    for (int tp = 0; tp < 4; ++tp) { cw[tp][0] = *(const LAS f32x4*)(cst + 192 + 64 * tp + 8 * st_c); cw[tp][1] = *(const LAS f32x4*)(cst + 192 + 64 * tp + 8 * st_c + 4); }
    cbias[0] = *(const LAS f32x4*)(cst + 448 + 8 * st_c); cbias[1] = *(const LAS f32x4*)(cst + 448 + 8 * st_c + 4);
    static_assert((NC + 4) % 3 == 0, "the tile loop is unrolled by three (one prefetch register set per residue)");
    for (int it0 = 0; it0 < NC + 4; it0 += 3) {
#pragma unroll
      for (int rr = 0; rr < 3; ++rr) { const int it = it0 + rr;
        __syncthreads();
        if (it < NC) { LAS unsigned char* xs = lds + R3_X + (it & 1) * 8704; const v4u xp = rr == 0 ? xp0 : rr == 1 ? xp1 : xp2, xh = rr == 0 ? xh0 : rr == 1 ? xh1 : xh2;
            *(LAS v4u*)(xs + (st_t * 64 + 8 * st_c) * 2) = xp; if (tid < 24) *(LAS v4u*)(xs + ((64 + st_t) * 64 + 8 * st_c) * 2) = xh; }
        if (it + 3 < NC) { if (rr == 0) R3_LOAD(it + 3, xp0, xh0); else if (rr == 1) R3_LOAD(it + 3, xp1, xh1); else R3_LOAD(it + 3, xp2, xh2); }
        if (it >= 1 && it - 1 < NC) { const int cn = it - 1; const LAS unsigned char* xs = lds + R3_X + (cn & 1) * 8704; LAS unsigned char* ub = lds + R3_UB + (cn & 1) * 9216; float u[8];
#pragma unroll
            for (int q = 0; q < 8; ++q) u[q] = cbias[q >> 2][q & 3];
            v4u xr[4];
#pragma unroll
            for (int tp = 0; tp < 4; ++tp) xr[tp] = *(const LAS v4u*)(xs + ((st_t + tp) * 64 + 8 * st_c) * 2);
#pragma unroll
            for (int tp = 0; tp < 4; ++tp) { float x[8]; unpack8(xr[tp], x);
                const f32x4 c0 = cw[tp][0], c1 = cw[tp][1];
                u[0] += c0.x * x[0]; u[1] += c0.y * x[1]; u[2] += c0.z * x[2]; u[3] += c0.w * x[3]; u[4] += c1.x * x[4]; u[5] += c1.y * x[5]; u[6] += c1.z * x[6]; u[7] += c1.w * x[7]; }
            *(LAS v4u*)(ub + (st_t * RW_LD + 8 * st_c) * 2) = pack8(u); }
        if (it >= 2 && it - 2 < NC) { const int cn = it - 2; const LAS unsigned char* ub = lds + R3_UB + (cn & 1) * 9216; LAS float* as = (LAS float*)(lds + R3_A + (cn & 1) * 16384); LAS unsigned short* bxs = (LAS unsigned short*)(lds + R3_BX + (cn & 1) * 8192);
            const int q0 = wave == 0 ? 0 : wave == 4 ? 1 : 2 * (wave >> 2), q1 = wave == 0 ? 1 : wave == 4 ? 4 : 2 * (wave >> 2) + 2;
            bfx8 af[2];
#pragma unroll
            for (int ks = 0; ks < 2; ++ks) af[ks] = ldfrag(ub + ((16 * tt + fr) * RW_LD + 32 * ks + 8 * fq) * 2);
#pragma unroll 1
            for (int q = q0; q < q1; ++q) { const int ch = 16 * q + fr;
                bfx8 wf[2][2]; float uu[4];
#pragma unroll
                for (int ks = 0; ks < 2; ++ks)
#pragma unroll
                    for (int g = 0; g < 2; ++g) wf[ks][g] = ldfrag(Wg + ((64 * g + ch) * RW_LD + 32 * ks + 8 * fq) * 2);
                const float cb0 = cst[ch], cb1 = cst[64 + ch], cb2 = cst[128 + ch];
#pragma unroll
                for (int j = 0; j < 4; ++j) uu[j] = bf1(*(const LAS bf16*)(ub + ((16 * tt + 4 * fq + j) * RW_LD + ch) * 2));
                __builtin_amdgcn_sched_barrier(0);
                f32x4 G0 = (f32x4){0.f, 0.f, 0.f, 0.f}, G1 = (f32x4){0.f, 0.f, 0.f, 0.f};
#pragma unroll
                for (int ks = 0; ks < 2; ++ks) { G0 = MFMA16(af[ks], wf[ks][0], G0); G1 = MFMA16(af[ks], wf[ks][1], G1); }
                __builtin_amdgcn_sched_barrier(0);
#pragma unroll
                for (int j = 0; j < 4; ++j) { const int t = 16 * tt + 4 * fq + j, o = t * 64 + ch; const float r = sigmoid_f(G0[j] + cb0), ig = sigmoid_f(G1[j] + cb1), loga2 = 1.44269504f * cb2 * r;
                    const float av = __builtin_amdgcn_exp2f(loga2); as[o] = av; bxs[o] = bf16_1(__builtin_amdgcn_sqrtf(fmaxf(1.0f - av * av, 0.f)) * (ig * uu[j])); } } }
        if (wave == 0 && it >= 3 && it - 3 < NC) { const int cn = it - 3; const LAS float* as = (const LAS float*)(lds + R3_A + (cn & 1) * 16384); const LAS unsigned short* bxs = (const LAS unsigned short*)(lds + R3_BX + (cn & 1) * 8192);
            LAS unsigned short* hs = (LAS unsigned short*)(lds + R3_H + (cn & 1) * 8192); float h = hstate;
            const LAS float* asl = as + lane; const LAS unsigned short* bxl = bxs + lane; LAS unsigned short* hsl = hs + lane;
#define R3_BASES(t0_) unsigned ab_ = (unsigned)(uintptr_t)(asl + (t0_) * 64), bb_ = (unsigned)(uintptr_t)(bxl + (t0_) * 64), hb_ = (unsigned)(uintptr_t)(hsl + (t0_) * 64); asm volatile("" : "+v"(ab_), "+v"(bb_), "+v"(hb_)); \
            const LAS float* ap = (const LAS float*)(uintptr_t)ab_; const LAS unsigned short* bp = (const LAS unsigned short*)(uintptr_t)bb_; LAS unsigned short* hp = (LAS unsigned short*)(uintptr_t)hb_
            if (!dir) {
#pragma unroll 1
                for (int tb = 0; tb < 64; tb += 16) { float av[16], bv[16]; R3_BASES(tb);
#pragma unroll
                    for (int k = 0; k < 16; ++k) { av[k] = ap[k * 64]; bv[k] = bf1(bp[k * 64]); }
#pragma unroll
                    for (int k = 0; k < 16; ++k) { h = av[k] * h + bv[k]; av[k] = h; }
#pragma unroll
                    for (int k = 0; k < 16; ++k) hp[k * 64] = bf16_1(av[k]); }
            } else {
#pragma unroll 1
                for (int tb = 0; tb < 64; tb += 16) { float av[16], bv[16]; R3_BASES(48 - tb);
#pragma unroll
                    for (int k = 0; k < 16; ++k) { av[k] = ap[(15 - k) * 64]; bv[k] = bf1(bp[(15 - k) * 64]); }
#pragma unroll
                    for (int k = 0; k < 16; ++k) { h = av[k] * h + bv[k]; av[k] = h; }
#pragma unroll
                    for (int k = 0; k < 16; ++k) hp[(15 - k) * 64] = bf16_1(av[k]); }
            }
            hstate = h; }
        if (it >= 4) { const int cn = it - 4; R3_TILE(cn, ic, Ls, a0); (void)Ls; const int pos = a0 + st_t;
            *(v4u*)(out + (size_t)R3_ROW(ic, pos) * 1024 + blk * 64 + 8 * st_c) = *(const LAS v4u*)(lds + R3_H + (cn & 1) * 8192 + (st_t * 64 + 8 * st_c) * 2); }
      }
    }
#undef R3_BASES
#undef R3_TILE
#undef R3_ROW
#undef R3_LOAD
}

__global__ void __launch_bounds__(512, 2) fwd_kernel(Args a) {
    extern __shared__ __attribute__((aligned(16))) unsigned char lds_raw[];
    LAS unsigned char* lds = (LAS unsigned char*)lds_raw;
    const int tid = threadIdx.x; const int G = gridDim.x;
    volatile LAS unsigned* MISC = (volatile LAS unsigned*)(lds + LDSCTL_OFF);
    if (tid < 64) MISC[tid] = 0u;
    if (tid < 44) ((volatile LAS unsigned*)(lds + TBL_OFF))[tid] = ((const unsigned*)__builtin_amdgcn_kernarg_segment_ptr())[tid];
    __syncthreads();
    (void)xcd_barrier_post((unsigned*)(a.ws + WS_CTL) + CW_BAR, MISC + 8);
#define EPI_ALIGN true
#define BARRIER() do { XcdBarrier b_; b_.bar = (unsigned*)(wsp(lds) + WS_CTL) + CW_BAR; b_.x = xb_xcc_id(); b_.st = (volatile LAS unsigned*)(lds + LDSCTL_OFF) + 8; xcd_barrier(b_); } while (0)
#define GBARRIER() grp_barrier((unsigned*)(wsp(lds) + WS_CTL) + CW_GBAR, (unsigned*)(wsp(lds) + WS_CTL) + CW_BAR, (volatile LAS unsigned*)(lds + LDSCTL_OFF) + 8)
#define WS(off) (wsp(lds) + (off))
    phase_mods(lds, 0, 1, (int)blockIdx.x, G, true); phase_convert(0, lds);
    grp_barrier_post((unsigned*)(wsp(lds) + WS_CTL) + CW_GBAR);
    BARRIER();
    grp_barrier_census((unsigned*)(wsp(lds) + WS_CTL) + CW_GBAR, (volatile LAS unsigned*)(lds + LDSCTL_OFF) + 8);
    __syncthreads();
#define FAST() (__builtin_amdgcn_readfirstlane((int)((volatile LAS unsigned*)(lds + LDSCTL_OFF))[10]) == 32 && __builtin_amdgcn_readfirstlane((int)((volatile LAS unsigned*)(lds + LDSCTL_OFF))[11]) == 1)
#define SUBBAR(cw, gw, n) sub_barrier((unsigned*)(wsp(lds) + WS_CTL) + CW_GBAR, (unsigned*)(wsp(lds) + WS_CTL) + CW_BAR, cw((unsigned)blockIdx.x & 7u), gw((unsigned)blockIdx.x & 7u), n)
#pragma unroll 1
    for (int l = 0; l < NL; ++l) {
        const float* modsb = (const float*)WS(WS_MODS);
        const size_t wset = (size_t)(l & 1) * WSET_STRIDE;
        { NormArgs na{l == 0 ? inp(lds, 0) : outp(lds), l == 0 ? inp(lds, 2) : (const float*)WS(WS_HC), outp(lds), (float*)WS(WS_HC), l == 0 ? nullptr : (const bf16*)WS(WS_Y),
                      modsb + (size_t)(l - 1) * 9 * MODW + 8 * D, 0.5f, inp(lds, 6) + (size_t)(l * 3) * D, modsb + (size_t)l * 9 * MODW, (bf16*)WS(WS_XN), nullptr};
            if (l == 0) norm_all(na); else if (!FAST()) norm_tail(na); }
        if (l == 0 || !FAST()) GBARRIER();
#pragma unroll 1
        for (int half = 0; half < 2; ++half) {
            { pg8::Gemm g{(const bf16*)WS(WS_XN), (const bf16*)WS(wset + WS_W1T) + (size_t)half * 2 * DFF * D, M, 2 * DFF, D, D, D}; const int lat = (l == NL - 1 && half == 1);
                pg8::StaticOrder S; S.init(lat ? NB * SEQ : M, 2 * DFF, G, (int)blockIdx.x, lat);
                EpiSwiGLU E{(bf16*)WS(WS_SO)};
                pg8::gemm_phase<EpiSwiGLU, pg8::StaticOrder, EPI_ALIGN, true>(lds, g, S, E); }
            if (l + 1 < NL && blockIdx.x >= 96) convert_in_tail(l + 1, half, lds);
            GBARRIER();
            { pg8::Gemm g{(const bf16*)WS(WS_SO), (const bf16*)WS(wset + WS_W2T) + (size_t)half * D * DFF, M, D, DFF, DFF, DFF}; EpiStoreBf16 E{(bf16*)WS(WS_Y)};
#pragma unroll 1
                for (int part = 0; part < 2; ++part) {
                    if (part) GBARRIER();
                    const bool tailwg = ((int)blockIdx.x >> 3) < PO_TAILSLOTS;
                    if (part == 0 || tailwg) { PanelOrder S{(int)blockIdx.x, part ? 32 * PO_FULL : 0, part ? PO_TAILSLOTS : 32, part ? 1 : PO_FULL}; pg8::gemm_phase<EpiStoreBf16, PanelOrder, EPI_ALIGN, true>(lds, g, S, E); }
                    if (part && (!tailwg || FAST())) {
                    if (tailwg) SUBBAR(GB_SUBA, GB_SUBAGEN, (unsigned)PO_TAILSLOTS);
                    const bool fin = (half == 1 && l == NL - 1); const int ln = half ? l + 1 : l;
                    NormArgs na{(l == 0 && half == 0) ? inp(lds, 0) : outp(lds), (l == 0 && half == 0) ? inp(lds, 2) : (const float*)WS(WS_HC), outp(lds), (float*)WS(WS_HC), (const bf16*)WS(WS_Y),
                                modsb + (size_t)l * 9 * MODW + (half ? 8 : 2) * D, 0.5f, fin ? inp(lds, 19) : inp(lds, 6) + (size_t)(ln * 3 + (half ? 0 : 1)) * D,
                                modsb + (size_t)(fin ? l : ln) * 9 * MODW + (half ? 0 : 3) * D, (bf16*)WS(WS_XN), fin ? outp(lds) : nullptr};
                    norm_span(na, tailwg, PO_TAILSLOTS, PO_READYP); } } }
            if (half) BARRIER(); else GBARRIER();
            if (half == 0) {
                { NormArgs na{l == 0 ? inp(lds, 0) : outp(lds), l == 0 ? inp(lds, 2) : (const float*)WS(WS_HC), outp(lds), (float*)WS(WS_HC), (const bf16*)WS(WS_Y),
                              modsb + (size_t)l * 9 * MODW + 2 * D, 0.5f, inp(lds, 6) + (size_t)(l * 3 + 1) * D, modsb + (size_t)l * 9 * MODW + 3 * D, (bf16*)WS(WS_XN), nullptr};
                    if (!FAST()) norm_tail(na); }
                if (!FAST()) GBARRIER();
                { pg8::Gemm g{(const bf16*)WS(WS_XN), (const bf16*)WS(wset + WS_WINT), M, INP, D, D, D}; pg8::StaticOrder S; S.init(M, INP, G, (int)blockIdx.x);
                    EpiInProj E{(bf16*)WS(WS_PA), (bf16*)WS(WS_PB), (bf16*)WS(WS_PC), (bf16*)WS(WS_PG), (bf16*)WS(WS_GTB)};
                    pg8::gemm_phase<EpiInProj, pg8::StaticOrder, EPI_ALIGN, true>(lds, g, S, E); }
                BARRIER();
                for (int i0 = blockIdx.x; i0 < 256; i0 += G) scan_mlstm2(((i0 & 7) << 5) | (i0 >> 3), l, lds);
                for (int i0 = blockIdx.x; i0 < 256; i0 += G) scan_hgrn2(((i0 & 7) << 5) | (i0 >> 3), l, lds);
                for (int i0 = blockIdx.x; i0 < 256; i0 += G) scan_rglru3(((i0 & 7) << 5) | (i0 >> 3), l, lds);
                GBARRIER();
                phase_fin((bf16*)WS(WS_PA), (bf16*)WS(WS_PB), (bf16*)WS(WS_PC), (const bf16*)WS(WS_SO), (bf16*)WS(WS_Y3));
                GBARRIER();
                { pg8::StaticOrder S; S.init(l == NL - 1 ? NB * SEQ : M, D, G, (int)blockIdx.x, l == NL - 1);
#pragma unroll 1
                    for (int br = 0; br < 3; ++br) {
                        pg8::Gemm g{(const bf16*)WS(WS_Y3) + br * 1024, (const bf16*)WS(wset + WS_WBRT) + br * 1024, M, D, 1024, 3072, 3072}; EpiBranch E{(const bf16*)WS(WS_PG), (bf16*)WS(WS_XN), br};
                        pg8::gemm_phase<EpiBranch, pg8::StaticOrder, EPI_ALIGN, true>(lds, g, S, E); } }
                if (l + 1 < NL && blockIdx.x >= 64) { __syncthreads(); phase_mods(lds, l + 1, l + 2, (int)blockIdx.x - 64, 192, false); }
                BARRIER();
                { pg8::Gemm g{(const bf16*)WS(WS_XN), (const bf16*)WS(wset + WS_WOT), M, D, D, D, D}; EpiStoreBf16 E{(bf16*)WS(WS_Y)};
#define NA_WOUT NormArgs na{outp(lds), (const float*)WS(WS_HC), outp(lds), (float*)WS(WS_HC), (const bf16*)WS(WS_Y), modsb + (size_t)l * 9 * MODW + 5 * D, 1.0f, \
                                inp(lds, 6) + (size_t)(l * 3 + 2) * D, modsb + (size_t)l * 9 * MODW + 6 * D, (bf16*)WS(WS_XN), nullptr}
#pragma unroll 1
                    for (int part = 0; part < 2; ++part) {
                        if (part) GBARRIER();
                        const bool tailwg = ((int)blockIdx.x >> 3) < WO_TAILSLOTS;
                        if (part == 0 || tailwg) { PanelOrder S{(int)blockIdx.x, part ? 32 * WO_FULL : 0, part ? WO_TAILSLOTS : 32, part ? 2 : WO_FULL}; pg8::gemm_phase<EpiStoreBf16, PanelOrder, EPI_ALIGN, true>(lds, g, S, E); }
                        if (part && (!tailwg || FAST())) {
                            if (tailwg) SUBBAR(GB_SUBB, GB_SUBBGEN, (unsigned)WO_TAILSLOTS);
                            NA_WOUT; norm_span(na, tailwg, WO_TAILSLOTS, WO_READYP); } }
                    GBARRIER();
                    if (!FAST()) { NA_WOUT; norm_tail(na, WO_READYP); } }
#undef NA_WOUT
                if (!FAST()) GBARRIER();
            }
        }
    }
    { const float* modsb = (const float*)WS(WS_MODS);
        NormArgs na{outp(lds), (const float*)WS(WS_HC), outp(lds), (float*)WS(WS_HC), (const bf16*)WS(WS_Y), modsb + (size_t)(NL - 1) * 9 * MODW + 8 * D, 0.5f, inp(lds, 19), modsb, (bf16*)WS(WS_XN), outp(lds)};
        if (!FAST()) norm_tail(na); }
#undef FAST
#undef SUBBAR
#undef BARRIER
#undef GBARRIER
#undef WS
#undef EPI_ALIGN
}

extern "C" void kernel_launch(void* const* d_in, const int* in_sizes, int n_in, void* d_out, int out_size, void* d_ws, size_t ws_size, hipStream_t stream) {
    static int grid = 0;
    if (grid == 0) {
        if (n_in != 20 || out_size != NB * SEQ * D || ws_size < WS_END) { fprintf(stderr, "kernel_launch: unexpected shapes / workspace (%d inputs, out %d, ws %zu < %zu)\n", n_in, out_size, ws_size, (size_t)WS_END); grid = -1; return; }
        int dev = 0, cus = 0, per_cu = 0;
        if (hipGetDevice(&dev) != hipSuccess || hipDeviceGetAttribute(&cus, hipDeviceAttributeMultiprocessorCount, dev) != hipSuccess) { grid = -1; return; }
        if (hipFuncSetAttribute((const void*)fwd_kernel, hipFuncAttributeMaxDynamicSharedMemorySize, LDS_BYTES) != hipSuccess) { fprintf(stderr, "kernel_launch: hipFuncSetAttribute failed\n"); grid = -1; return; }
        if (hipOccupancyMaxActiveBlocksPerMultiprocessor(&per_cu, (const void*)fwd_kernel, 512, LDS_BYTES) != hipSuccess || per_cu < 1) { fprintf(stderr, "kernel_launch: occupancy query says %d\n", per_cu); }
        (void)hipGetLastError();
        if (cus < 256) { fprintf(stderr, "kernel_launch: built for a 256-CU device (got %d)\n", cus); grid = -1; return; }
        grid = 256;
    }
    if (grid < 0) return;
    (void)hipMemsetAsync((char*)d_ws + WS_CTL, 0, CTL_ZERO_BYTES, stream);
    Args a{};
    for (int i = 0; i < 20; ++i) a.in[i] = (const float*)d_in[i];
    a.out = (float*)d_out; a.ws = (unsigned char*)d_ws;
    hipLaunchKernelGGL(fwd_kernel, dim3(grid), dim3(512), LDS_BYTES, stream, a);
}
```
